# Optimizing an MI355X kernel written in HIP

```python
import jax
import jax.numpy as jnp
from jax import lax
import numpy as np

D_MODEL = 1024
BATCH = 4
SEQ = 4096
DEPTH = 1

HGRN_HEADS = 8
HGRN_DK = D_MODEL // HGRN_HEADS
HGRN_DV = D_MODEL // HGRN_HEADS
HGRN_CHUNK = 64
MOBA_HEADS = 8
MOBA_HD = D_MODEL // MOBA_HEADS
MOBA_BLOCK = 256
MOBA_TOPK = 3
MOBA_QCHUNK = 16
ROPE_THETA = 10000.0
D_FF = ((8 * D_MODEL + 3 * 256 - 1) // (3 * 256)) * 256
N_PROJ = 2 * HGRN_HEADS * HGRN_DK + 2 * HGRN_HEADS * HGRN_DV + 3 * MOBA_HEADS * MOBA_HD + 2 * D_MODEL
DN_ALPHA = (2.0 * DEPTH) ** 0.25
DN_BETA = (8.0 * DEPTH) ** -0.25
LN_EPS = 1e-5
RMS_EPS = 1e-6

kernel_name = 'hybrid_hgrn2_moba_deepnorm'


def layer_norm(x, w, b):
    xf = x.astype(jnp.float32)
    mu = jnp.mean(xf, axis=-1, keepdims=True)
    var = jnp.mean(jnp.square(xf - mu), axis=-1, keepdims=True)
    y = (xf - mu) * lax.rsqrt(var + LN_EPS) * w.astype(jnp.float32) + b.astype(jnp.float32)
    return y.astype(x.dtype)


def rms_norm(x, w):
    xf = x.astype(jnp.float32)
    y = xf * lax.rsqrt(jnp.mean(jnp.square(xf), axis=-1, keepdims=True) + RMS_EPS)
    return y * w.astype(jnp.float32)


def apply_rope(t):
    S, hd = t.shape[1], t.shape[-1]
    half = hd // 2
    inv_freq = ROPE_THETA ** (-jnp.arange(half, dtype=jnp.float32) / half)
    ang = jnp.arange(S, dtype=jnp.float32)[:, None] * inv_freq[None, :]
    cos = jnp.cos(ang)[None, :, None, :]
    sin = jnp.sin(ang)[None, :, None, :]
    tf = t.astype(jnp.float32)
    t1, t2 = tf[..., :half], tf[..., half:]
    return jnp.concatenate([t1 * cos - t2 * sin, t2 * cos + t1 * sin], axis=-1).astype(t.dtype)


def hgrn2_mixer(q, f_logit, inp, lb):
    B, S, H, dk = q.shape
    dv = inp.shape[-1]
    C = HGRN_CHUNK
    nc = S // C
    lb = lb.reshape(H, dk)
    z = f_logit.astype(jnp.float32)
    log_f = jnp.logaddexp(jnp.log(lb), jnp.log1p(-lb) + jax.nn.log_sigmoid(z))
    k = (1.0 - lb) * jax.nn.sigmoid(-z)
    qf = jax.nn.silu(q.astype(jnp.float32))
    v = inp.astype(jnp.float32)

    def to_chunks(t):
        return t.reshape(B, nc, C, H, t.shape[-1]).transpose(1, 0, 3, 2, 4)

    causal = jnp.tril(jnp.ones((C, C), dtype=bool))[:, :, None]

    def step(state, xs):
        qc, kc, vc, lfc = xs
        G = jnp.cumsum(lfc, axis=2)
        diff = G[:, :, :, None, :] - G[:, :, None, :, :]
        decay = jnp.exp(jnp.where(causal, diff, -jnp.inf))
        scores = jnp.einsum('bhtsd,bhtd,bhsd->bhts', decay, qc, kc)
        o = jnp.einsum('bhts,bhsv->bhtv', scores, vc) + jnp.einsum('bhtd,bhdv->bhtv', qc * jnp.exp(G), state)
        g_last = G[:, :, -1, :]
        new_state = jnp.exp(g_last)[..., None] * state + jnp.einsum(
            'bhsd,bhsv->bhdv', kc * jnp.exp(g_last[:, :, None, :] - G), vc)
        return new_state, o

    s0 = jnp.zeros((B, H, dk, dv), jnp.float32)
    _, o = lax.scan(step, s0, (to_chunks(qf), to_chunks(k), to_chunks(v), to_chunks(log_f)))
    return o.transpose(1, 0, 3, 2, 4).reshape(B, S, H, dv)


def moba_attention(q, k, v):
    B, S, H, hd = q.shape
    BLK = MOBA_BLOCK
    QC = MOBA_QCHUNK
    nb = -(-S // BLK)
    Sp = nb * BLK
    nq = S // QC
    topk = min(MOBA_TOPK, nb)
    scale = hd ** -0.5
    qh = q.transpose(0, 2, 1, 3)
    pad = ((0, 0), (0, 0), (0, Sp - S), (0, 0))
    kb = jnp.pad(k.transpose(0, 2, 1, 3), pad).reshape(B, H, nb, BLK, hd)
    vb = jnp.pad(v.transpose(0, 2, 1, 3), pad).reshape(B, H, nb, BLK, hd)
    k_mean = jnp.mean(kb.astype(jnp.float32), axis=3)
    gate = jnp.einsum('bhsd,bhnd->bhsn', qh.astype(jnp.float32), k_mean)
    own = jnp.arange(S) // BLK
    past = jnp.arange(nb)[None, :] < own[:, None]
    gate = jnp.where(past, gate, -jnp.inf)
    _, sel = lax.top_k(gate, topk)

    q_ch = qh.reshape(B, H, nq, QC, hd).transpose(2, 0, 1, 3, 4)
    sel_ch = sel.reshape(B, H, nq, QC, topk).transpose(2, 0, 1, 3, 4)
    gather = jax.vmap(jax.vmap(lambda blocks, ix: blocks[ix]))

    def attend(args):
        ci, qc, sc = args
        start = ci * QC
        qpos = start + jnp.arange(QC)
        ob = start // BLK
        kpos = ob * BLK + jnp.arange(BLK)
        k_own = lax.dynamic_index_in_dim(kb, ob, axis=2, keepdims=False)
        v_own = lax.dynamic_index_in_dim(vb, ob, axis=2, keepdims=False)
        k_sel = gather(kb, sc)
        v_sel = gather(vb, sc)
        s_sel = jnp.einsum('bhqd,bhqnkd->bhqnk', qc, k_sel).astype(jnp.float32) * scale
        valid = sc < (qpos // BLK)[:, None]
        s_sel = jnp.where(valid[..., None], s_sel, -jnp.inf).reshape(B, H, QC, topk * BLK)
        s_own = jnp.einsum('bhqd,bhkd->bhqk', qc, k_own).astype(jnp.float32) * scale
        s_own = jnp.where(kpos[None, :] <= qpos[:, None], s_own, -jnp.inf)
        p = jax.nn.softmax(jnp.concatenate([s_sel, s_own], axis=-1), axis=-1).astype(qc.dtype)
        p_sel = p[..., :topk * BLK].reshape(B, H, QC, topk, BLK)
        p_own = p[..., topk * BLK:]
        return (jnp.einsum('bhqnk,bhqnkd->bhqd', p_sel, v_sel)
                + jnp.einsum('bhqk,bhkd->bhqd', p_own, v_own))

    o = lax.map(attend, (jnp.arange(nq), q_ch, sel_ch))
    return o.transpose(1, 0, 3, 2, 4).reshape(B, S, H, hd)


def hybrid_layer(x, w_in, lb, hgrn_norm_w, w_branch_a, w_branch_b, b_gate, w_out,
                 ln1_w, ln1_b, w_ffn_in, w_ffn_down, ln2_w, ln2_b):
    B, S, D = x.shape
    proj = jnp.einsum('bsd,dn->bsn', x, w_in)
    sizes = (HGRN_HEADS * HGRN_DK, HGRN_HEADS * HGRN_DK, HGRN_HEADS * HGRN_DV, HGRN_HEADS * HGRN_DV,
             MOBA_HEADS * MOBA_HD, MOBA_HEADS * MOBA_HD, MOBA_HEADS * MOBA_HD, 2 * D_MODEL)
    offsets = np.cumsum(sizes)[:-1].tolist()
    hq, hf, hi, hg, mq, mk, mv, gate_logits = jnp.split(proj, offsets, axis=-1)

    o_a = hgrn2_mixer(hq.reshape(B, S, HGRN_HEADS, HGRN_DK), hf.reshape(B, S, HGRN_HEADS, HGRN_DK),
                      hi.reshape(B, S, HGRN_HEADS, HGRN_DV), lb)
    y_a = rms_norm(o_a, hgrn_norm_w.reshape(HGRN_HEADS, HGRN_DV)) * jax.nn.silu(
        hg.reshape(B, S, HGRN_HEADS, HGRN_DV).astype(jnp.float32))
    y_a = y_a.reshape(B, S, HGRN_HEADS * HGRN_DV).astype(x.dtype)

    q_b = apply_rope(mq.reshape(B, S, MOBA_HEADS, MOBA_HD))
    k_b = apply_rope(mk.reshape(B, S, MOBA_HEADS, MOBA_HD))
    y_b = moba_attention(q_b, k_b, mv.reshape(B, S, MOBA_HEADS, MOBA_HD)).reshape(B, S, MOBA_HEADS * MOBA_HD)

    z_a = jnp.einsum('bsc,cd->bsd', y_a, w_branch_a)
    z_b = jnp.einsum('bsc,cd->bsd', y_b, w_branch_b)
    g_a, g_b = jnp.split(jax.nn.sigmoid(gate_logits + b_gate), 2, axis=-1)
    mixed = jnp.einsum('bsc,cd->bsd', g_a * z_a + g_b * z_b, w_out)
    x = layer_norm(DN_ALPHA * x + mixed, ln1_w, ln1_b)

    h = jnp.einsum('bsd,df->bsf', x, w_ffn_in)
    h_gate, h_up = jnp.split(h, 2, axis=-1)
    y = jnp.einsum('bsf,fd->bsd', jax.nn.silu(h_gate) * h_up, w_ffn_down)
    return layer_norm(DN_ALPHA * x + y, ln2_w, ln2_b)


def setup_inputs(seed: int = 0) -> dict:
    key = jax.random.key(seed)
    ks = jax.random.split(key, 16)

    def nrm(k, shape, scale):
        return jax.random.normal(k, shape, jnp.float32) * scale

    d_a = HGRN_HEADS * HGRN_DV
    d_b = MOBA_HEADS * MOBA_HD
    return {
        'x': nrm(ks[0], (BATCH, SEQ, D_MODEL), 1.0),
        'w_in': nrm(ks[1], (DEPTH, D_MODEL, N_PROJ), D_MODEL ** -0.5),
        'lb_logits': nrm(ks[2], (DEPTH + 1, HGRN_HEADS * HGRN_DK), 0.1),
        'hgrn_norm_w': 1.0 + nrm(ks[3], (DEPTH, d_a), 0.02),
        'w_branch_a': nrm(ks[4], (DEPTH, d_a, D_MODEL), d_a ** -0.5),
        'w_branch_b': nrm(ks[5], (DEPTH, d_b, D_MODEL), d_b ** -0.5),
        'b_gate': nrm(ks[6], (DEPTH, 2 * D_MODEL), 0.1),
        'w_out': nrm(ks[7], (DEPTH, D_MODEL, D_MODEL), D_MODEL ** -0.5 * DN_BETA),
        'ln1_w': 1.0 + nrm(ks[8], (DEPTH, D_MODEL), 0.02),
        'ln1_b': nrm(ks[9], (DEPTH, D_MODEL), 0.02),
        'w_ffn_in': nrm(ks[10], (DEPTH, D_MODEL, 2 * D_FF), D_MODEL ** -0.5),
        'w_ffn_down': nrm(ks[11], (DEPTH, D_FF, D_MODEL), D_FF ** -0.5 * DN_BETA),
        'ln2_w': 1.0 + nrm(ks[12], (DEPTH, D_MODEL), 0.02),
        'ln2_b': nrm(ks[13], (DEPTH, D_MODEL), 0.02),
    }


def reference(x, w_in, lb_logits, hgrn_norm_w, w_branch_a, w_branch_b, b_gate, w_out,
              ln1_w, ln1_b, w_ffn_in, w_ffn_down, ln2_w, ln2_b):
    lower_bounds = jnp.cumsum(jax.nn.softmax(lb_logits.astype(jnp.float32), axis=0), axis=0)
    h = x
    for l in range(DEPTH):
        h = hybrid_layer(h, w_in[l], lower_bounds[l], hgrn_norm_w[l], w_branch_a[l], w_branch_b[l],
                         b_gate[l], w_out[l], ln1_w[l], ln1_b[l], w_ffn_in[l], w_ffn_down[l],
                         ln2_w[l], ln2_b[l])
    return h
```

```cpp
#include <hip/hip_runtime.h>
#include <hip/hip_cooperative_groups.h>
#include <cstdio>
namespace cg = cooperative_groups;

#define LAS __attribute__((address_space(3)))
typedef unsigned short bf16_t;
typedef short bf16x8 __attribute__((ext_vector_type(8)));
typedef short s16x4 __attribute__((ext_vector_type(4)));
typedef float f32x4 __attribute__((ext_vector_type(4)));
typedef unsigned u32x4 __attribute__((ext_vector_type(4)));
typedef unsigned u32x2 __attribute__((ext_vector_type(2)));
typedef _Float16 h16x8 __attribute__((ext_vector_type(8)));

#ifndef N_LAUNCH_MODE
#define N_LAUNCH_MODE 1
#endif

constexpr int T_ = 16384, D_ = 1024, S_ = 4096, DFF = 2816;
constexpr float DN_ALPHA = 1.189207115002721f;
constexpr size_t MB = 1u << 20;
constexpr size_t O_XB = 0, O_MM = 0, O_WIN = 32 * MB, O_WBR = 50 * MB, O_WOUT = 54 * MB, O_WFI = 56 * MB, O_WFD = 67 * MB,
                 O_COS = 73 * MB, O_SIN = 74 * MB, O_KM = 75 * MB, O_LB = 75 * MB + 256 * 1024, O_GT = 75 * MB + 512 * 1024, O_SEG = 76 * MB,
                 O_QF = 92 * MB, O_LF = 124 * MB, O_VH = 156 * MB, O_SG = 188 * MB, O_YA = 220 * MB,
                 O_MQ = 92 * MB, O_MK = 124 * MB, O_MV = 156 * MB, O_YB = 188 * MB, O_R1 = 92 * MB, O_X1B = 220 * MB, O_ACT = 76 * MB, O_R2 = 164 * MB;
constexpr int LDS_BYTES = 131072;
constexpr int NPHASE = 12;

struct Args { const float* in[14]; float* out; unsigned char* ws; int ph_lo, ph_hi; };

__device__ __forceinline__ unsigned cvt_pk_bf16(float lo, float hi) { unsigned r; asm("v_cvt_pk_bf16_f32 %0, %1, %2" : "=v"(r) : "v"(lo), "v"(hi)); return r; }
__device__ __forceinline__ float bf2f(unsigned short b) { return __uint_as_float(((unsigned)b) << 16); }
__device__ __forceinline__ float bflo(unsigned w) { return __uint_as_float(w << 16); }
__device__ __forceinline__ float bfhi(unsigned w) { return __uint_as_float(w & 0xffff0000u); }
__device__ __forceinline__ float sigmoidf_(float x) { return __builtin_amdgcn_rcpf(1.0f + __expf(-x)); }
__device__ __forceinline__ float siluf_(float x) { return x * sigmoidf_(x); }
__device__ __forceinline__ u32x4 pack8(const f32x4& a, const f32x4& b) { u32x4 w; w.x = cvt_pk_bf16(a[0], a[1]); w.y = cvt_pk_bf16(a[2], a[3]); w.z = cvt_pk_bf16(b[0], b[1]); w.w = cvt_pk_bf16(b[2], b[3]); return w; }

namespace pg8 {
constexpr int BM = 256, BK = 64, HALF = 128, HTB = HALF * BK * 2, STAGE_BYTES = 8 * HTB, NXCD = 8, WGM = 8;
__device__ __forceinline__ int lds_byte(int r, int c) { const int st = (r >> 4) * 2 + (c >> 5), rr = r & 15, cc = c & 31, ob = rr * 64 + cc * 2; return st * 1024 + (ob ^ (((ob >> 9) & 1) << 5)); }
__device__ __forceinline__ void stage_rc(int b, int& R, int& C) { const int st = b / 1024, sb = b % 1024, swz = sb ^ (((sb >> 9) & 1) << 5); R = (st >> 1) * 16 + swz / 64; C = (st & 1) * 32 + (swz % 64) / 2; }
__device__ __forceinline__ int perm32(int rho) { const int n = rho >> 4, i = rho & 15; return 8 * (i >> 2) + 4 * n + (i & 3); }
struct Unit { int pm, pn; };
struct Gemm { const bf16_t* A; const bf16_t* A2; const bf16_t* Bt; int M, N, K, lda, ksplit; };
struct StaticOrder {
    int nM, nN, nwg, G, c;
    __device__ void init(int M, int N, int G_, int c_) { nM = M / BM; nN = N / BM; nwg = nM * nN; G = G_; c = c_; }
    __device__ bool next(int i, Unit& u) const {
        const long L = (long)i * G + c; if (L >= nwg) return false;
        int wgid = (int)L; { const int q = nwg / NXCD, r = nwg % NXCD, xcd = wgid % NXCD, off = wgid / NXCD; wgid = (xcd < r ? xcd * (q + 1) : r * (q + 1) + (xcd - r) * q) + off; }
        const int nig = WGM * nN, gid = wgid / nig, fm = gid * WGM, gsz = (nM - fm) < WGM ? (nM - fm) : WGM;
        u.pm = fm + ((wgid % nig) % gsz); u.pn = (wgid % nig) / gsz; return true;
    }
};
template <class Epi>
__device__ __forceinline__ void gemm_phase(LAS unsigned char* lds, const Gemm g, const StaticOrder& S, const Epi& E) {
    int tid_ = threadIdx.x; asm volatile("" : "+v"(tid_));
    const int tid = tid_, wid = __builtin_amdgcn_readfirstlane(tid >> 6), lane = tid & 63, wr = wid >> 2, wc = wid & 3, fr = lane & 15, fq = lane >> 4;
    const int K = g.K, nt = K / BK, ks = g.ksplit;
    unsigned voffA[2], voffB[2];
#pragma unroll
    for (int i = 0; i < 2; ++i) { int R, C; stage_rc(tid * 16 + i * 8192, R, C); const int Rb = (R & ~31) + perm32(R & 31);
        voffA[i] = (unsigned)(R * g.lda + C) * 2u; voffB[i] = (unsigned)(Rb * K + C) * 2u; }
    const size_t kstep = (size_t)(BK * 2);
    const size_t hstepA = (size_t)HALF * g.lda * 2, hstepB = (size_t)HALF * K * 2;
    const size_t tstepA = 2 * hstepA, tstepB = 2 * hstepB;
    const unsigned ldsw = (unsigned)wid * 1024u;
    const int aoff = lds_byte(wr * 64 + fr, fq * 8), boff = lds_byte(wc * 32 + fr, fq * 8);
#define PG8_SA(b, h) (((b) * 2 + (h)) * HTB)
#define PG8_SB(b, h) ((4 + (b) * 2 + (h)) * HTB)
#define PG8_STAGE(bufoff, gbase, voff) do { _Pragma("unroll") for (int _i = 0; _i < 2; ++_i) \
        __builtin_amdgcn_global_load_lds((const unsigned*)((const char*)(gbase) + (voff)[_i]), (LAS unsigned*)(lds + (bufoff) + ldsw + _i * 8192), 16, 0, 0); } while (0)
#define PG8_LDA(dst, b, h) do { _Pragma("unroll") for (int m = 0; m < 4; ++m) _Pragma("unroll") for (int k = 0; k < 2; ++k) dst[m][k] = *(const LAS bf16x8*)(lds + PG8_SA(b, h) + aoff + m * 2048 + k * 1024); } while (0)
#define PG8_LDB(dst, b, h) do { _Pragma("unroll") for (int n = 0; n < 2; ++n) _Pragma("unroll") for (int k = 0; k < 2; ++k) dst[n][k] = *(const LAS bf16x8*)(lds + PG8_SB(b, h) + boff + n * 2048 + k * 1024); } while (0)
#define PG8_MMA(ai, bj, At, Bt) do { __builtin_amdgcn_s_setprio(1); _Pragma("unroll") for (int m = 0; m < 4; ++m) _Pragma("unroll") for (int n = 0; n < 2; ++n) _Pragma("unroll") for (int k = 0; k < 2; ++k) \
        acc[ai][bj][m][n] = __builtin_amdgcn_mfma_f32_16x16x32_bf16(Bt[n][k], At[m][k], acc[ai][bj][m][n], 0, 0, 0); __builtin_amdgcn_s_setprio(0); } while (0)
#define PG8_WAIT_V(n) asm volatile("s_waitcnt vmcnt(" #n ")" ::: "memory")
#define PG8_WAIT_L(n) asm volatile("s_waitcnt lgkmcnt(" #n ")" ::: "memory")
#define PG8_BAR __builtin_amdgcn_s_barrier()
#define PG8_SCHED __builtin_amdgcn_sched_barrier(0)
    Unit cur, nxt; int ui = 0;
    if (!S.next(0, cur)) return;
    f32x4 acc[2][2][4][2];
#pragma unroll
    for (int a = 0; a < 2; ++a)
#pragma unroll
        for (int b = 0; b < 2; ++b)
#pragma unroll
            for (int m = 0; m < 4; ++m)
#pragma unroll
                for (int n = 0; n < 2; ++n) acc[a][b][m][n] = (f32x4){0.f, 0.f, 0.f, 0.f};
    bf16x8 At[4][2], B0[2][2], B1[2][2];
    const char* cA = (const char*)g.A + (size_t)cur.pm * tstepA; const char* cA2 = (const char*)g.A2 + (size_t)cur.pm * tstepA - (size_t)ks * kstep;
    const char* cB = (const char*)g.Bt + (size_t)cur.pn * tstepB;
    PG8_STAGE(PG8_SB(0, 0), cB, voffB); PG8_STAGE(PG8_SA(0, 0), cA, voffA); PG8_STAGE(PG8_SB(0, 1), cB + hstepB, voffB); PG8_STAGE(PG8_SA(0, 1), cA + hstepA, voffA);
    if (wr == 1) PG8_BAR;
    PG8_WAIT_V(4); PG8_BAR;
    PG8_STAGE(PG8_SB(1, 0), cB + kstep, voffB); PG8_STAGE(PG8_SA(1, 0), cA + kstep, voffA); PG8_STAGE(PG8_SB(1, 1), cB + hstepB + kstep, voffB);
    PG8_WAIT_V(6); PG8_BAR;
    for (;;) {
        const bool has_next = S.next(ui + 1, nxt);
        const char* nA = has_next ? (const char*)g.A + (size_t)nxt.pm * tstepA : cA; const char* nB = has_next ? (const char*)g.Bt + (size_t)nxt.pn * tstepB : cB;
        for (int t = 0; t < nt; t += 2) {
            const bool last = (t == nt - 2);
            if constexpr (Epi::HAS_MID) { if (t == ks) E.mid(acc, cur, wr, wc, fr, fq); }
            const char* a1 = ((t + 1) < ks ? cA : cA2) + (size_t)(t + 1) * kstep;
            const char* a2 = last ? nA : ((t + 2) < ks ? cA : cA2) + (size_t)(t + 2) * kstep; const char* b2 = last ? nB : cB + (size_t)(t + 2) * kstep;
            const char* a3 = a2 + kstep; const char* b3 = b2 + kstep;
            PG8_LDB(B0, 0, 0); PG8_SCHED; PG8_LDA(At, 0, 0); PG8_STAGE(PG8_SA(1, 1), a1 + hstepA, voffA);
            PG8_WAIT_L(8); PG8_BAR; PG8_WAIT_L(0); PG8_MMA(0, 0, At, B0); PG8_BAR; PG8_SCHED;
            PG8_LDB(B1, 0, 1); PG8_STAGE(PG8_SB(0, 0), b2, voffB);
            PG8_BAR; PG8_WAIT_L(0); PG8_MMA(0, 1, At, B1); PG8_BAR;
            PG8_LDA(At, 0, 1); PG8_STAGE(PG8_SA(0, 0), a2, voffA);
            PG8_BAR; PG8_WAIT_L(0); PG8_MMA(1, 0, At, B0); PG8_BAR; PG8_SCHED;
            PG8_STAGE(PG8_SB(0, 1), b2 + hstepB, voffB);
            PG8_WAIT_V(6); PG8_BAR; PG8_MMA(1, 1, At, B1); PG8_BAR;
            PG8_LDB(B0, 1, 0); PG8_SCHED; PG8_LDA(At, 1, 0); PG8_STAGE(PG8_SA(0, 1), a2 + hstepA, voffA);
            PG8_WAIT_L(8); PG8_BAR; PG8_WAIT_L(0); PG8_MMA(0, 0, At, B0); PG8_BAR; PG8_SCHED;
            PG8_LDB(B1, 1, 1); PG8_STAGE(PG8_SB(1, 0), b3, voffB);
            PG8_BAR; PG8_WAIT_L(0); PG8_MMA(0, 1, At, B1); PG8_BAR;
            PG8_LDA(At, 1, 1); PG8_STAGE(PG8_SA(1, 0), a3, voffA);
            PG8_BAR; PG8_WAIT_L(0); PG8_MMA(1, 0, At, B0); PG8_BAR; PG8_SCHED;
            PG8_STAGE(PG8_SB(1, 1), b3 + hstepB, voffB);
            PG8_WAIT_V(6); PG8_BAR; PG8_MMA(1, 1, At, B1); PG8_BAR;
        }
        E(acc, cur, wr, wc, fr, fq);
        if (!has_next) break;
#pragma unroll
        for (int a = 0; a < 2; ++a)
#pragma unroll
            for (int b = 0; b < 2; ++b)
#pragma unroll
                for (int m = 0; m < 4; ++m)
#pragma unroll
                    for (int n = 0; n < 2; ++n) acc[a][b][m][n] = (f32x4){0.f, 0.f, 0.f, 0.f};
        cur = nxt; cA = nA; cA2 = (const char*)g.A2 + (size_t)cur.pm * tstepA - (size_t)ks * kstep; cB = nB; ++ui;
    }
    PG8_WAIT_V(0);
    if (wr == 0) PG8_BAR;
    PG8_BAR;
#undef PG8_SA
#undef PG8_SB
#undef PG8_STAGE
#undef PG8_LDA
#undef PG8_LDB
#undef PG8_MMA
#undef PG8_WAIT_V
#undef PG8_WAIT_L
#undef PG8_BAR
#undef PG8_SCHED
}
}
using pg8::Unit;
typedef f32x4 Acc[2][2][4][2];

struct EpiProjA {
    static constexpr bool HAS_MID = false;
    bf16_t* QF; _Float16* LF; bf16_t* VH; bf16_t* SG; bf16_t* GA; bf16_t* GR; const float* lb; const float* bg;
    __device__ __forceinline__ void mid(Acc&, const Unit&, int, int, int, int) const {}
    __device__ __forceinline__ void operator()(const Acc& acc, const Unit& u, int wr, int wc, int fr, int fq) const {
        const int row0 = u.pm * 256 + wr * 64 + fr, seg = u.pn >> 2;
        if (seg < 4) {
            const int cs0 = (u.pn & 3) * 256 + wc * 32 + 8 * fq;
#pragma unroll
            for (int bj = 0; bj < 2; ++bj) {
                const int cs = cs0 + bj * 128;
                f32x4 l0 = {0.f, 0.f, 0.f, 0.f}, l1 = l0;
                if (seg == 1) { l0 = *(const f32x4*)(lb + cs); l1 = *(const f32x4*)(lb + cs + 4); }
#pragma unroll
                for (int ai = 0; ai < 2; ++ai)
#pragma unroll
                    for (int m = 0; m < 4; ++m) {
                        const size_t off = (size_t)(row0 + ai * 128 + m * 16) * 1024 + cs;
                        f32x4 v0 = acc[ai][bj][m][0], v1 = acc[ai][bj][m][1];
                        if (seg == 1) {
                            h16x8 hv;
#pragma unroll
                            for (int j = 0; j < 4; ++j) { hv[j] = (_Float16)__logf(l0[j] + (1.0f - l0[j]) * sigmoidf_(v0[j])); hv[4 + j] = (_Float16)__logf(l1[j] + (1.0f - l1[j]) * sigmoidf_(v1[j])); }
                            *(h16x8*)(LF + off) = hv;
                        } else {
                            if (seg == 0 || seg == 3) {
#pragma unroll
                                for (int j = 0; j < 4; ++j) { v0[j] = siluf_(v0[j]); v1[j] = siluf_(v1[j]); } }
                            const u32x4 pk = pack8(v0, v1);
                            if (seg == 0) *(u32x4*)(QF + off) = pk; else if (seg == 2) *(u32x4*)(VH + off) = pk; else *(u32x4*)(SG + off) = pk;
                        }
                        __builtin_amdgcn_sched_barrier(0);
                    }
            }
        } else {
            const int c = (u.pn - 16) * 128 + wc * 32 + 8 * fq;
            const f32x4 ba0 = *(const f32x4*)(bg + c), ba1 = *(const f32x4*)(bg + c + 4), bb0 = *(const f32x4*)(bg + 1024 + c), bb1 = *(const f32x4*)(bg + 1024 + c + 4);
#pragma unroll
            for (int ai = 0; ai < 2; ++ai)
#pragma unroll
                for (int m = 0; m < 4; ++m) {
                    const size_t off = (size_t)(row0 + ai * 128 + m * 16) * 1024 + c;
                    f32x4 a0, a1, r0, r1;
#pragma unroll
                    for (int j = 0; j < 4; ++j) {
                        a0[j] = sigmoidf_(acc[ai][0][m][0][j] + ba0[j]); a1[j] = sigmoidf_(acc[ai][0][m][1][j] + ba1[j]);
                        r0[j] = sigmoidf_(acc[ai][1][m][0][j] + bb0[j]) / a0[j]; r1[j] = sigmoidf_(acc[ai][1][m][1][j] + bb1[j]) / a1[j]; }
                    *(u32x4*)(GA + off) = pack8(a0, a1); *(u32x4*)(GR + off) = pack8(r0, r1); __builtin_amdgcn_sched_barrier(0);
                }
        }
    }
};
struct EpiProjB {
    static constexpr bool HAS_MID = false;
    bf16_t* MQ; bf16_t* MK; bf16_t* MV; float* KM; const float* COS; const float* SIN;
    __device__ __forceinline__ void mid(Acc&, const Unit&, int, int, int, int) const {}
    __device__ __forceinline__ void operator()(const Acc& acc, const Unit& u, int wr, int wc, int fr, int fq) const {
        const int row0 = u.pm * 256 + wr * 64 + fr, seg = u.pn >> 2;
        if (seg == 2) {
            const int cs0 = (u.pn & 3) * 256 + wc * 32 + 8 * fq;
#pragma unroll
            for (int bj = 0; bj < 2; ++bj)
#pragma unroll
                for (int ai = 0; ai < 2; ++ai)
#pragma unroll
                    for (int m = 0; m < 4; ++m)
                        *(u32x4*)(MV + (size_t)(row0 + ai * 128 + m * 16) * 1024 + cs0 + bj * 128) = pack8(acc[ai][bj][m][0], acc[ai][bj][m][1]);
        } else {
            const int head = 2 * (u.pn & 3) + (wc >> 1), i0 = 32 * (wc & 1) + 8 * fq;
            const float sc = seg == 0 ? 0.08838834764831845f * 1.4426950408889634f : 1.0f;
            f32x4 s1a = {0.f, 0.f, 0.f, 0.f}, s1b = s1a, s2a = s1a, s2b = s1a;
#pragma unroll
            for (int ai = 0; ai < 2; ++ai)
#pragma unroll
                for (int m = 0; m < 4; ++m) {
                    const int row = row0 + ai * 128 + m * 16, pos = row & (S_ - 1);
                    const f32x4 c0 = *(const f32x4*)(COS + pos * 64 + i0), c1 = *(const f32x4*)(COS + pos * 64 + i0 + 4);
                    const f32x4 n0 = *(const f32x4*)(SIN + pos * 64 + i0), n1 = *(const f32x4*)(SIN + pos * 64 + i0 + 4);
                    const f32x4 x1a = acc[ai][0][m][0], x1b = acc[ai][0][m][1], x2a = acc[ai][1][m][0], x2b = acc[ai][1][m][1];
                    f32x4 o1a = (x1a * c0 - x2a * n0) * sc, o1b = (x1b * c1 - x2b * n1) * sc, o2a = (x2a * c0 + x1a * n0) * sc, o2b = (x2b * c1 + x1b * n1) * sc;
                    const size_t off = (size_t)row * 1024 + head * 128 + i0;
                    if (seg == 0) { *(u32x4*)(MQ + off) = pack8(o1a, o1b); *(u32x4*)(MQ + off + 64) = pack8(o2a, o2b); }
                    else { *(u32x4*)(MK + off) = pack8(o1a, o1b); *(u32x4*)(MK + off + 64) = pack8(o2a, o2b); }
                    s1a += o1a; s1b += o1b; s2a += o2a; s2b += o2b;
                    asm volatile("" : "+v"(s1a), "+v"(s1b), "+v"(s2a), "+v"(s2b));
                    __builtin_amdgcn_sched_barrier(0);
                }
            if (seg == 1) {
#pragma unroll
                for (int sh = 1; sh < 16; sh <<= 1)
#pragma unroll
                    for (int j = 0; j < 4; ++j) { s1a[j] += __shfl_xor(s1a[j], sh); s1b[j] += __shfl_xor(s1b[j], sh); s2a[j] += __shfl_xor(s2a[j], sh); s2b[j] += __shfl_xor(s2b[j], sh); }
                if (fr == 0) {
                    float* km = KM + ((size_t)((u.pm >> 4) * 8 + head) * 16 + (u.pm & 15)) * 128 + i0;
#pragma unroll
                    for (int j = 0; j < 4; ++j) { atomicAdd(km + j, s1a[j] * (1.0f / 256.0f)); atomicAdd(km + 4 + j, s1b[j] * (1.0f / 256.0f)); atomicAdd(km + 64 + j, s2a[j] * (1.0f / 256.0f)); atomicAdd(km + 68 + j, s2b[j] * (1.0f / 256.0f)); }
                }
            }
        }
    }
};
struct EpiBranch {
    static constexpr bool HAS_MID = true;
    const bf16_t* GA; const bf16_t* GR; bf16_t* MM;
    __device__ __forceinline__ void mid(Acc& acc, const Unit& u, int wr, int wc, int fr, int fq) const {
        int row0 = u.pm * 256 + wr * 64 + fr; const int c0 = u.pn * 256 + wc * 32 + 8 * fq;
        asm volatile("" : "+v"(row0));
#pragma unroll
        for (int ai = 0; ai < 2; ++ai)
#pragma unroll
            for (int m = 0; m < 4; ++m)
#pragma unroll
                for (int bj = 0; bj < 2; ++bj) {
                    const u32x4 w = *(const u32x4*)(GR + (size_t)(row0 + ai * 128 + m * 16) * 1024 + c0 + bj * 128);
                    acc[ai][bj][m][0] *= (f32x4){bflo(w.x), bfhi(w.x), bflo(w.y), bfhi(w.y)}; acc[ai][bj][m][1] *= (f32x4){bflo(w.z), bfhi(w.z), bflo(w.w), bfhi(w.w)}; __builtin_amdgcn_sched_barrier(0);
                }
    }
    __device__ __forceinline__ void operator()(const Acc& acc, const Unit& u, int wr, int wc, int fr, int fq) const {
        const int row0 = u.pm * 256 + wr * 64 + fr, c0 = u.pn * 256 + wc * 32 + 8 * fq;
#pragma unroll
        for (int ai = 0; ai < 2; ++ai)
#pragma unroll
            for (int m = 0; m < 4; ++m)
#pragma unroll
                for (int bj = 0; bj < 2; ++bj) {
                    const size_t off = (size_t)(row0 + ai * 128 + m * 16) * 1024 + c0 + bj * 128;
                    const u32x4 w = *(const u32x4*)(GA + off);
                    *(u32x4*)(MM + off) = pack8(acc[ai][bj][m][0] * (f32x4){bflo(w.x), bfhi(w.x), bflo(w.y), bfhi(w.y)}, acc[ai][bj][m][1] * (f32x4){bflo(w.z), bfhi(w.z), bflo(w.w), bfhi(w.w)}); __builtin_amdgcn_sched_barrier(0);
                }
    }
};
struct EpiRes {
    static constexpr bool HAS_MID = false;
    const float* res; float* dst;
    __device__ __forceinline__ void mid(Acc&, const Unit&, int, int, int, int) const {}
    __device__ __forceinline__ void operator()(const Acc& acc, const Unit& u, int wr, int wc, int fr, int fq) const {
        const int row0 = u.pm * 256 + wr * 64 + fr, c0 = u.pn * 256 + wc * 32 + 8 * fq;
#pragma unroll
        for (int ai = 0; ai < 2; ++ai)
#pragma unroll
            for (int m = 0; m < 4; ++m)
#pragma unroll
                for (int bj = 0; bj < 2; ++bj) {
                    const size_t off = (size_t)(row0 + ai * 128 + m * 16) * 1024 + c0 + bj * 128;
                    const f32x4 r0 = *(const f32x4*)(res + off), r1 = *(const f32x4*)(res + off + 4);
                    *(f32x4*)(dst + off) = r0 * DN_ALPHA + acc[ai][bj][m][0]; *(f32x4*)(dst + off + 4) = r1 * DN_ALPHA + acc[ai][bj][m][1]; __builtin_amdgcn_sched_barrier(0);
                }
    }
};
struct EpiFfnIn {
    static constexpr bool HAS_MID = false;
    bf16_t* ACT;
    __device__ __forceinline__ void mid(Acc&, const Unit&, int, int, int, int) const {}
    __device__ __forceinline__ void operator()(const Acc& acc, const Unit& u, int wr, int wc, int fr, int fq) const {
        const int row0 = u.pm * 256 + wr * 64 + fr, c0 = u.pn * 128 + wc * 32 + 8 * fq;
#pragma unroll
        for (int ai = 0; ai < 2; ++ai)
#pragma unroll
            for (int m = 0; m < 4; ++m) {
                f32x4 a0, a1;
#pragma unroll
                for (int j = 0; j < 4; ++j) { a0[j] = siluf_(acc[ai][0][m][0][j]) * acc[ai][1][m][0][j]; a1[j] = siluf_(acc[ai][0][m][1][j]) * acc[ai][1][m][1][j]; }
                *(u32x4*)(ACT + (size_t)(row0 + ai * 128 + m * 16) * DFF + c0) = pack8(a0, a1);
            }
    }
};

__device__ __forceinline__ int perm_in(int n) {
    if (n < 4096) return n;
    if (n < 6144) { const int q = (n - 4096) >> 8, tc = n & 255; return 7168 + 1024 * (tc >> 7) + 128 * q + (tc & 127); }
    if (n < 8192) { const int u = n - 6144, seg = u >> 10, q = (u & 1023) >> 8, tc = u & 255, bj = tc >> 7, hh = (tc & 127) >> 6, i = tc & 63; return 4096 + 1024 * seg + 128 * (2 * q + hh) + 64 * bj + i; }
    return 6144 + (n - 8192);
}
__device__ __forceinline__ int perm_ffi(int n) { const int pn = n >> 8, tc = n & 255; return DFF * (tc >> 7) + 128 * pn + (tc & 127); }

__device__ __forceinline__ void prep_phase(LAS unsigned char* lds, const Args& a) {
    int tid_ = threadIdx.x; asm volatile("" : "+v"(tid_));
    const int tid = tid_, nb = gridDim.x, bid = blockIdx.x;
    unsigned char* ws = a.ws;
    {   const float4* x4 = (const float4*)a.in[0]; u32x2* xb = (u32x2*)(ws + O_XB); const size_t n4 = (size_t)T_ * D_ / 4;
        for (size_t i = (size_t)bid * 512 + tid; i < n4; i += (size_t)nb * 512) { const float4 v = x4[i]; u32x2 w; w.x = cvt_pk_bf16(v.x, v.y); w.y = cvt_pk_bf16(v.z, v.w); xb[i] = w; } }
    {   float* COS = (float*)(ws + O_COS); float* SIN = (float*)(ws + O_SIN);
        for (int i = bid * 512 + tid; i < S_ * 64; i += nb * 512) {
            const int pos = i >> 6, f = i & 63;
            const float inv = exp2f(-(float)f * (13.287712379549449f / 64.0f));
            const float angf = (float)pos * inv;
            const double ang = (double)angf;
            const double j = rint(ang * 0.6366197723675814); const float r = (float)(ang - j * 1.5707963267948966); const float r2 = r * r;
            const float sn = r * (1.0f + r2 * (-1.6666667e-1f + r2 * (8.3333333e-3f + r2 * (-1.9841270e-4f + r2 * (2.7557319e-6f + r2 * (-2.5052108e-8f))))));
            const float cs = 1.0f + r2 * (-0.5f + r2 * (4.1666667e-2f + r2 * (-1.3888889e-3f + r2 * (2.4801587e-5f + r2 * (-2.7557319e-7f + r2 * 2.0876757e-9f)))));
            const int q = ((int)j) & 3;
            const float s = (q == 0) ? sn : (q == 1) ? cs : (q == 2) ? -sn : -cs;
            const float c = (q == 0) ? cs : (q == 1) ? -sn : (q == 2) ? -cs : sn;
            COS[i] = c; SIN[i] = s;
        }
        float* KM = (float*)(ws + O_KM);
        for (int i = bid * 512 + tid; i < 4 * 8 * 16 * 128; i += nb * 512) KM[i] = 0.f;
        float* LB = (float*)(ws + O_LB); const float* lbl = a.in[2];
        for (int i = bid * 512 + tid; i < 1024; i += nb * 512) LB[i] = 1.0f / (1.0f + expf(lbl[1024 + i] - lbl[i]));
    }
    LAS float* tl = (LAS float*)lds;
    for (int ti = bid; ti < 5184; ti += nb) {
        const float* src; bf16_t* dst; int nsrc, ldd, koff, ntn, mode, loc;
        if (ti < 2304) { src = a.in[1]; dst = (bf16_t*)(ws + O_WIN); nsrc = 9216; ldd = 1024; koff = 0; ntn = 144; mode = 1; loc = ti; }
        else if (ti < 2560) { src = a.in[5]; dst = (bf16_t*)(ws + O_WBR); nsrc = 1024; ldd = 2048; koff = 0; ntn = 16; mode = 0; loc = ti - 2304; }
        else if (ti < 2816) { src = a.in[4]; dst = (bf16_t*)(ws + O_WBR); nsrc = 1024; ldd = 2048; koff = 1024; ntn = 16; mode = 0; loc = ti - 2560; }
        else if (ti < 3072) { src = a.in[7]; dst = (bf16_t*)(ws + O_WOUT); nsrc = 1024; ldd = 1024; koff = 0; ntn = 16; mode = 0; loc = ti - 2816; }
        else if (ti < 4480) { src = a.in[10]; dst = (bf16_t*)(ws + O_WFI); nsrc = 5632; ldd = 1024; koff = 0; ntn = 88; mode = 2; loc = ti - 3072; }
        else { src = a.in[11]; dst = (bf16_t*)(ws + O_WFD); nsrc = 1024; ldd = 2816; koff = 0; ntn = 16; mode = 0; loc = ti - 4480; }
        const int n0 = (loc % ntn) * 64, k0 = (loc / ntn) * 64;
        {   const int nn = tid & 63, kk0 = tid >> 6; const int n = n0 + nn; const int on = mode == 1 ? perm_in(n) : (mode == 2 ? perm_ffi(n) : n);
#pragma unroll
            for (int i = 0; i < 8; ++i) { const int kk = kk0 + 8 * i; tl[kk * 65 + nn] = src[(size_t)(k0 + kk) * nsrc + on]; } }
        __syncthreads();
        {   const int nn = tid >> 3, kc = tid & 7; float v[8];
#pragma unroll
            for (int e = 0; e < 8; ++e) v[e] = tl[(8 * kc + e) * 65 + nn];
            u32x4 w; w.x = cvt_pk_bf16(v[0], v[1]); w.y = cvt_pk_bf16(v[2], v[3]); w.z = cvt_pk_bf16(v[4], v[5]); w.w = cvt_pk_bf16(v[6], v[7]);
            *(u32x4*)(dst + (size_t)(n0 + nn) * ldd + koff + k0 + 8 * kc) = w; }
        __syncthreads();
    }
}

constexpr int HQ = 0, HK = 17408, HKT = 34816, HVT = 53248, HP = 71680, HST = 80896, HEG = 115712, HGS = 116224, HRS = 118272;
__device__ __forceinline__ f32x4 mfma16(bf16x8 a, bf16x8 b, f32x4 c) { return __builtin_amdgcn_mfma_f32_16x16x32_bf16(a, b, c, 0, 0, 0); }
template <bool FULL>
__device__ __forceinline__ void hgrn_item(LAS unsigned char* lds, const Args& a, int item) {
    unsigned char* ws = a.ws;
    int tid_ = threadIdx.x; asm volatile("" : "+v"(tid_));
    const int tid = tid_, wid = tid >> 6, lane = tid & 63, fr = lane & 15, g = lane >> 4;
    const int b = item >> 6, h = (item >> 3) & 7, seg = item & 7;
    const int tok0 = b * S_ + seg * 512, col0 = h * 128;
    const bf16_t* QF = (const bf16_t*)(ws + O_QF); const _Float16* LF = (const _Float16*)(ws + O_LF); const bf16_t* VH = (const bf16_t*)(ws + O_VH); const bf16_t* SG = (const bf16_t*)(ws + O_SG);
    bf16_t* YA = (bf16_t*)(ws + O_YA); float* SEG = (float*)(ws + O_SEG); float* GT = (float*)(ws + O_GT);
    LAS float* EG = (LAS float*)(lds + HEG); LAS float* GS = (LAS float*)(lds + HGS); LAS float* RS = (LAS float*)(lds + HRS);
    f32x4 st[8];
#pragma unroll
    for (int vt = 0; vt < 8; ++vt) st[vt] = (f32x4){0.f, 0.f, 0.f, 0.f};
    if (FULL) {
        for (int i = 0; i < seg; ++i) {
            const int it = item - seg + i;
            const float* sp = SEG + (size_t)it * 16384; const float* gp = GT + it * 128;
            float e[4];
#pragma unroll
            for (int r = 0; r < 4; ++r) e[r] = __expf(gp[16 * wid + 4 * g + r]);
#pragma unroll
            for (int vt = 0; vt < 8; ++vt)
#pragma unroll
                for (int r = 0; r < 4; ++r) st[vt][r] = e[r] * st[vt][r] + sp[(16 * wid + 4 * g + r) * 128 + 16 * vt + fr];
        }
    }
    const int d = tid & 127, tg = tid >> 7;
    float gsum = 0.f;
    for (int c = 0; c < 8; ++c) {
        const int t0 = tok0 + 64 * c;
        const size_t gb = (size_t)(t0 + 16 * tg) * 1024 + col0 + d;
        float lf[16], G[16];
        unsigned short vv[16], qq[16];
#pragma unroll
        for (int j = 0; j < 16; ++j) { lf[j] = (float)LF[gb + (size_t)j * 1024]; vv[j] = VH[gb + (size_t)j * 1024]; if (FULL) qq[j] = QF[gb + (size_t)j * 1024]; }
        float run = 0.f;
#pragma unroll
        for (int j = 0; j < 16; ++j) { run += lf[j]; G[j] = run; }
        GS[tg * 128 + d] = run;
        __syncthreads();
        const float g0 = GS[d], g1 = GS[128 + d], g2 = GS[256 + d], g3 = GS[384 + d];
        const float pre = tg == 0 ? 0.f : (tg == 1 ? g0 : (tg == 2 ? g0 + g1 : g0 + g1 + g2));
        const float glast = g0 + g1 + g2 + g3;
        if (tg == 0) EG[d] = __expf(glast);
        gsum += glast;
        {
            unsigned kp[8], vp[8];
#pragma unroll
            for (int j = 0; j < 16; j += 2) {
                const float G0 = G[j] + pre, G1 = G[j + 1] + pre;
                const float k0 = (1.0f - __expf(lf[j])) * __expf(-G0), k1 = (1.0f - __expf(lf[j + 1])) * __expf(-G1);
                const unsigned kw = cvt_pk_bf16(k0, k1);
                kp[j >> 1] = kw; vp[j >> 1] = (unsigned)vv[j] | ((unsigned)vv[j + 1] << 16);
                if (FULL) {
                    const unsigned qw = cvt_pk_bf16(bf2f(qq[j]) * __expf(G0), bf2f(qq[j + 1]) * __expf(G1));
                    *(LAS unsigned short*)(lds + HK + (16 * tg + j) * 272 + d * 2) = (unsigned short)(kw & 0xffff);
                    *(LAS unsigned short*)(lds + HK + (16 * tg + j + 1) * 272 + d * 2) = (unsigned short)(kw >> 16);
                    *(LAS unsigned short*)(lds + HQ + (16 * tg + j) * 272 + d * 2) = (unsigned short)(qw & 0xffff);
                    *(LAS unsigned short*)(lds + HQ + (16 * tg + j + 1) * 272 + d * 2) = (unsigned short)(qw >> 16);
                }
            }
            *(LAS u32x4*)(lds + HKT + d * 144 + tg * 32) = (u32x4){kp[0], kp[1], kp[2], kp[3]}; *(LAS u32x4*)(lds + HKT + d * 144 + tg * 32 + 16) = (u32x4){kp[4], kp[5], kp[6], kp[7]};
            *(LAS u32x4*)(lds + HVT + d * 144 + tg * 32) = (u32x4){vp[0], vp[1], vp[2], vp[3]}; *(LAS u32x4*)(lds + HVT + d * 144 + tg * 32 + 16) = (u32x4){vp[4], vp[5], vp[6], vp[7]};
        }
        if (FULL) {
#pragma unroll
            for (int vt = 0; vt < 8; ++vt) { u32x2 w; w.x = cvt_pk_bf16(st[vt][0], st[vt][1]); w.y = cvt_pk_bf16(st[vt][2], st[vt][3]);
                *(LAS u32x2*)(lds + HST + (16 * vt + fr) * 272 + (16 * wid + 4 * g) * 2) = w; }
        }
        __syncthreads();
        if (FULL) {
#pragma unroll
            for (int q = 0; q < 2; ++q) {
                const int idx = 2 * wid + q, stl = idx >> 2, ttl = idx & 3;
                f32x4 sc = {0.f, 0.f, 0.f, 0.f};
                if (stl <= ttl) {
#pragma unroll
                    for (int kk = 0; kk < 4; ++kk) {
                        const bf16x8 ka = *(const LAS bf16x8*)(lds + HK + (16 * stl + fr) * 272 + (32 * kk + 8 * g) * 2);
                        const bf16x8 qb = *(const LAS bf16x8*)(lds + HQ + (16 * ttl + fr) * 272 + (32 * kk + 8 * g) * 2);
                        sc = mfma16(ka, qb, sc);
                    }
                }
                const int tq = 16 * ttl + fr, s0 = 16 * stl + 4 * g;
                u32x2 w; w.x = cvt_pk_bf16(s0 <= tq ? sc[0] : 0.f, s0 + 1 <= tq ? sc[1] : 0.f); w.y = cvt_pk_bf16(s0 + 2 <= tq ? sc[2] : 0.f, s0 + 3 <= tq ? sc[3] : 0.f);
                *(LAS u32x2*)(lds + HP + tq * 144 + s0 * 2) = w;
            }
        }
        f32x4 oacc[4];
        if (FULL) {
            const int ttl = wid & 3;
#pragma unroll
            for (int i = 0; i < 4; ++i) {
                const int vt = 4 * (wid >> 2) + i; f32x4 o = {0.f, 0.f, 0.f, 0.f};
#pragma unroll
                for (int kk = 0; kk < 4; ++kk) {
                    const bf16x8 sa = *(const LAS bf16x8*)(lds + HST + (16 * vt + fr) * 272 + (32 * kk + 8 * g) * 2);
                    const bf16x8 qb = *(const LAS bf16x8*)(lds + HQ + (16 * ttl + fr) * 272 + (32 * kk + 8 * g) * 2);
                    o = mfma16(sa, qb, o);
                }
                oacc[i] = o;
            }
        }
        {
            bf16x8 ka[2];
#pragma unroll
            for (int kk = 0; kk < 2; ++kk) ka[kk] = *(const LAS bf16x8*)(lds + HKT + (16 * wid + fr) * 144 + (32 * kk + 8 * g) * 2);
            float eg[4];
#pragma unroll
            for (int r = 0; r < 4; ++r) eg[r] = EG[16 * wid + 4 * g + r];
#pragma unroll
            for (int vt = 0; vt < 8; ++vt) {
                f32x4 L = st[vt];
#pragma unroll
                for (int kk = 0; kk < 2; ++kk) { const bf16x8 vb = *(const LAS bf16x8*)(lds + HVT + (16 * vt + fr) * 144 + (32 * kk + 8 * g) * 2); L = mfma16(ka[kk], vb, L); }
#pragma unroll
                for (int r = 0; r < 4; ++r) st[vt][r] = eg[r] * L[r];
            }
        }
        if (FULL) {
            __syncthreads();
            const int ttl = wid & 3, tq = 16 * ttl + fr;
            float ss = 0.f;
#pragma unroll
            for (int i = 0; i < 4; ++i) {
                const int vt = 4 * (wid >> 2) + i; f32x4 o = oacc[i];
#pragma unroll
                for (int kk = 0; kk < 2; ++kk) {
                    const bf16x8 va = *(const LAS bf16x8*)(lds + HVT + (16 * vt + fr) * 144 + (32 * kk + 8 * g) * 2);
                    const bf16x8 pb = *(const LAS bf16x8*)(lds + HP + tq * 144 + (32 * kk + 8 * g) * 2);
                    o = mfma16(va, pb, o);
                }
                oacc[i] = o; ss += o[0] * o[0] + o[1] * o[1] + o[2] * o[2] + o[3] * o[3];
            }
            ss += __shfl_xor(ss, 16); ss += __shfl_xor(ss, 32);
            if (g == 0) RS[(wid >> 2) * 64 + tq] = ss;
            __syncthreads();
            const float rn = rsqrtf((RS[tq] + RS[64 + tq]) * (1.0f / 128.0f) + 1e-6f);
            const float* nw = a.in[3] + col0;
#pragma unroll
            for (int i = 0; i < 4; ++i) {
                const int v0 = 16 * (4 * (wid >> 2) + i) + 4 * g;
                const size_t off = (size_t)(t0 + tq) * 1024 + col0 + v0;
                const u32x2 sg = *(const u32x2*)(SG + off); const f32x4 w4 = *(const f32x4*)(nw + v0);
                u32x2 w; w.x = cvt_pk_bf16(oacc[i][0] * rn * w4[0] * bflo(sg.x), oacc[i][1] * rn * w4[1] * bfhi(sg.x));
                w.y = cvt_pk_bf16(oacc[i][2] * rn * w4[2] * bflo(sg.y), oacc[i][3] * rn * w4[3] * bfhi(sg.y));
                *(u32x2*)(YA + off) = w;
            }
        }
    }
    if (!FULL) {
        float* sp = SEG + (size_t)item * 16384;
#pragma unroll
        for (int vt = 0; vt < 8; ++vt)
#pragma unroll
            for (int r = 0; r < 4; ++r) sp[(16 * wid + 4 * g + r) * 128 + 16 * vt + fr] = st[vt][r];
        if (tg == 0) GT[item * 128 + d] = gsum;
    }
    __syncthreads();
}

constexpr int MKM = 0, MSEL = 8192, MKB = 9216, MVB = MKB + 2 * 17408, KST = 272, VST = 288;
template <int OFF> __device__ __forceinline__ s16x4 tr_read(unsigned vb) { s16x4 r; asm volatile("ds_read_b64_tr_b16 %0, %1 offset:%2" : "=&v"(r) : "v"(vb), "i"(OFF) : "memory"); return r; }
template <int C, int VT0> __device__ __forceinline__ void pv_quad(f32x4 (&O)[2][8], unsigned vb, const bf16x8 (&pf)[2][2]) {
    const s16x4 a0 = tr_read<(32 * C) * VST + 32 * (VT0 + 0)>(vb), b0 = tr_read<(32 * C + 16) * VST + 32 * (VT0 + 0)>(vb);
    const s16x4 a1 = tr_read<(32 * C) * VST + 32 * (VT0 + 1)>(vb), b1 = tr_read<(32 * C + 16) * VST + 32 * (VT0 + 1)>(vb);
    const s16x4 a2 = tr_read<(32 * C) * VST + 32 * (VT0 + 2)>(vb), b2 = tr_read<(32 * C + 16) * VST + 32 * (VT0 + 2)>(vb);
    const s16x4 a3 = tr_read<(32 * C) * VST + 32 * (VT0 + 3)>(vb), b3 = tr_read<(32 * C + 16) * VST + 32 * (VT0 + 3)>(vb);
    asm volatile("s_waitcnt lgkmcnt(0)" ::: "memory");
    __builtin_amdgcn_sched_barrier(0);
    const bf16x8 v0 = {a0[0], a0[1], a0[2], a0[3], b0[0], b0[1], b0[2], b0[3]}, v1 = {a1[0], a1[1], a1[2], a1[3], b1[0], b1[1], b1[2], b1[3]};
    const bf16x8 v2 = {a2[0], a2[1], a2[2], a2[3], b2[0], b2[1], b2[2], b2[3]}, v3 = {a3[0], a3[1], a3[2], a3[3], b3[0], b3[1], b3[2], b3[3]};
#pragma unroll
    for (int qs = 0; qs < 2; ++qs) {
        O[qs][VT0 + 0] = mfma16(v0, pf[qs][C], O[qs][VT0 + 0]); O[qs][VT0 + 1] = mfma16(v1, pf[qs][C], O[qs][VT0 + 1]);
        O[qs][VT0 + 2] = mfma16(v2, pf[qs][C], O[qs][VT0 + 2]); O[qs][VT0 + 3] = mfma16(v3, pf[qs][C], O[qs][VT0 + 3]);
    }
}
__device__ __forceinline__ void moba_item(LAS unsigned char* lds, const Args& a, int b, int h, int j) {
    unsigned char* ws = a.ws;
    int tid_ = threadIdx.x; asm volatile("" : "+v"(tid_));
    const int tid = tid_, wid = tid >> 6, lane = tid & 63, fr = lane & 15, g = lane >> 4;
    const bf16_t* MQ = (const bf16_t*)(ws + O_MQ); const bf16_t* MK = (const bf16_t*)(ws + O_MK); const bf16_t* MV = (const bf16_t*)(ws + O_MV);
    bf16_t* YB = (bf16_t*)(ws + O_YB); const float* KMg = (const float*)(ws + O_KM) + (size_t)(b * 8 + h) * 2048;
    const int tokb = b * S_, qrow0 = tokb + 256 * j, col0 = h * 128;
    LAS float* KM = (LAS float*)(lds + MKM); LAS unsigned* SEL = (LAS unsigned*)(lds + MSEL);
    *(LAS f32x4*)(lds + MKM + tid * 16) = *(const f32x4*)(KMg + tid * 4);
    __syncthreads();
    {
        const int q = tid >> 1, half = tid & 1;
        const bf16_t* qp = MQ + (size_t)(qrow0 + q) * 1024 + col0 + 64 * half;
        u32x4 qw[8];
#pragma unroll
        for (int i = 0; i < 8; ++i) qw[i] = *(const u32x4*)(qp + 8 * i);
        float b0 = -INFINITY, b1 = -INFINITY, b2 = -INFINITY; int i0 = -1, i1 = -1, i2 = -1;
        for (int n = 0; n < j; ++n) {
            const LAS float* kp = KM + n * 128 + 64 * half; float s = 0.f;
#pragma unroll
            for (int i = 0; i < 8; ++i) { const f32x4 ka = *(const LAS f32x4*)(kp + 8 * i), kb = *(const LAS f32x4*)(kp + 8 * i + 4);
                s += bflo(qw[i].x) * ka[0] + bfhi(qw[i].x) * ka[1] + bflo(qw[i].y) * ka[2] + bfhi(qw[i].y) * ka[3] + bflo(qw[i].z) * kb[0] + bfhi(qw[i].z) * kb[1] + bflo(qw[i].w) * kb[2] + bfhi(qw[i].w) * kb[3]; }
            s += __shfl_xor(s, 1);
            if (s > b0) { b2 = b1; i2 = i1; b1 = b0; i1 = i0; b0 = s; i0 = n; }
            else if (s > b1) { b2 = b1; i2 = i1; b1 = s; i1 = n; }
            else if (s > b2) { b2 = s; i2 = n; }
        }
        unsigned m = 0; if (i0 >= 0) m |= 1u << i0; if (i1 >= 0) m |= 1u << i1; if (i2 >= 0) m |= 1u << i2;
        if (half == 0) SEL[q] = m;
    }
    __syncthreads();
    bf16x8 qf[2][4]; unsigned selm[2]; f32x4 O[2][8]; float mrow[2], lrow[2];
#pragma unroll
    for (int qs = 0; qs < 2; ++qs) {
        const int t = 32 * wid + 16 * qs + fr;
#pragma unroll
        for (int kk = 0; kk < 4; ++kk) qf[qs][kk] = *(const bf16x8*)(MQ + (size_t)(qrow0 + t) * 1024 + col0 + 32 * kk + 8 * g);
        selm[qs] = SEL[t]; mrow[qs] = -INFINITY; lrow[qs] = 0.f;
#pragma unroll
        for (int vt = 0; vt < 8; ++vt) O[qs][vt] = (f32x4){0.f, 0.f, 0.f, 0.f};
    }
    const int ntile = 4 * (j + 1);
    const int lr = tid >> 3, lc = tid & 7;
    u32x4 kreg0, kreg1, vreg0, vreg1;
#define gload(it_) do { const size_t rb = (size_t)(tokb + 64 * (it_) + lr) * 1024 + col0 + 8 * lc; \
        kreg0 = *(const u32x4*)(MK + rb); kreg1 = *(const u32x4*)(MK + rb + 64); vreg0 = *(const u32x4*)(MV + rb); vreg1 = *(const u32x4*)(MV + rb + 64); } while (0)
#define lstore(buf_) do { *(LAS u32x4*)(lds + MKB + (buf_) * 17408 + lr * KST + 16 * lc) = kreg0; *(LAS u32x4*)(lds + MKB + (buf_) * 17408 + lr * KST + 16 * lc + 128) = kreg1; \
        *(LAS u32x4*)(lds + MVB + (buf_) * 18432 + lr * VST + 16 * lc) = vreg0; *(LAS u32x4*)(lds + MVB + (buf_) * 18432 + lr * VST + 16 * lc + 128) = vreg1; } while (0)
    gload(0); lstore(0);
    __syncthreads();
    for (int it = 0; it < ntile; ++it) {
        const int buf = it & 1, n = it >> 2, kt = it & 3;
        if (it + 1 < ntile) gload(it + 1);
        const bool own = (n == j);
        const bool sel0 = own || ((selm[0] >> n) & 1u), sel1 = own || ((selm[1] >> n) & 1u);
        const bool active = own ? (kt <= (wid >> 1)) : (__ballot(sel0 || sel1) != 0ull);
        if (active) {
            f32x4 s[2][4];
            const unsigned kb = MKB + buf * 17408;
#pragma unroll
            for (int at = 0; at < 4; ++at) {
                bf16x8 kf[4];
#pragma unroll
                for (int kk = 0; kk < 4; ++kk) kf[kk] = *(const LAS bf16x8*)(lds + kb + (16 * at + fr) * KST + (32 * kk + 8 * g) * 2);
#pragma unroll
                for (int qs = 0; qs < 2; ++qs) { f32x4 c = {0.f, 0.f, 0.f, 0.f};
#pragma unroll
                    for (int kk = 0; kk < 4; ++kk) c = mfma16(kf[kk], qf[qs][kk], c);
                    s[qs][at] = c; }
            }
            bf16x8 pf[2][2];
#pragma unroll
            for (int qs = 0; qs < 2; ++qs) {
                const bool sl = qs == 0 ? sel0 : sel1;
                const int qpos = 32 * wid + 16 * qs + fr;
                float mx = -INFINITY;
#pragma unroll
                for (int at = 0; at < 4; ++at)
#pragma unroll
                    for (int r = 0; r < 4; ++r) {
                        const int kpos = 64 * kt + 16 * at + 4 * g + r;
                        const bool ok = own ? (kpos <= qpos) : sl;
                        const float v = ok ? s[qs][at][r] : -INFINITY;
                        s[qs][at][r] = v; mx = fmaxf(mx, v);
                    }
                mx = fmaxf(mx, __shfl_xor(mx, 16)); mx = fmaxf(mx, __shfl_xor(mx, 32));
                const float mnew = fmaxf(mrow[qs], mx);
                const float msafe = mnew == -INFINITY ? 0.f : mnew;
                const float alpha = exp2f(mrow[qs] - msafe);
                mrow[qs] = mnew;
                float ps = 0.f; float p[4][4];
#pragma unroll
                for (int at = 0; at < 4; ++at)
#pragma unroll
                    for (int r = 0; r < 4; ++r) { p[at][r] = exp2f(s[qs][at][r] - msafe); ps += p[at][r]; }
                lrow[qs] = lrow[qs] * alpha + ps;
#pragma unroll
                for (int vt = 0; vt < 8; ++vt) O[qs][vt] *= alpha;
#pragma unroll
                for (int c = 0; c < 2; ++c) {
                    const unsigned w0 = cvt_pk_bf16(p[2 * c][0], p[2 * c][1]), w1 = cvt_pk_bf16(p[2 * c][2], p[2 * c][3]), w2 = cvt_pk_bf16(p[2 * c + 1][0], p[2 * c + 1][1]), w3 = cvt_pk_bf16(p[2 * c + 1][2], p[2 * c + 1][3]);
                    const u32x4 w = {w0, w1, w2, w3}; pf[qs][c] = __builtin_bit_cast(bf16x8, w);
                }
            }
            const unsigned vb = (unsigned)(MVB + buf * 18432 + (4 * g + (fr >> 2)) * VST + 8 * (fr & 3));
            pv_quad<0, 0>(O, vb, pf); pv_quad<0, 4>(O, vb, pf); pv_quad<1, 0>(O, vb, pf); pv_quad<1, 4>(O, vb, pf);
        }
        if (it + 1 < ntile) lstore(buf ^ 1);
        __syncthreads();
    }
#pragma unroll
    for (int qs = 0; qs < 2; ++qs) {
        float l = lrow[qs]; l += __shfl_xor(l, 16); l += __shfl_xor(l, 32);
        const float inv = 1.0f / l;
        const int t = 32 * wid + 16 * qs + fr;
        bf16_t* yp = YB + (size_t)(qrow0 + t) * 1024 + col0 + 4 * g;
#pragma unroll
        for (int vt = 0; vt < 8; ++vt) { u32x2 w; w.x = cvt_pk_bf16(O[qs][vt][0] * inv, O[qs][vt][1] * inv); w.y = cvt_pk_bf16(O[qs][vt][2] * inv, O[qs][vt][3] * inv); *(u32x2*)(yp + 16 * vt) = w; }
    }
    __syncthreads();
}

__device__ __forceinline__ void ln_phase(const float* src, const float* w, const float* bsh, float* dstf, bf16_t* dstb) {
    int tid_ = threadIdx.x; asm volatile("" : "+v"(tid_));
    const int tid = tid_, wid = tid >> 6, lane = tid & 63;
    for (int row = blockIdx.x * 8 + wid; row < T_; row += gridDim.x * 8) {
        const float* p = src + (size_t)row * 1024;
        f32x4 v[4]; float s = 0.f;
#pragma unroll
        for (int i = 0; i < 4; ++i) { v[i] = *(const f32x4*)(p + 256 * i + 4 * lane); s += v[i][0] + v[i][1] + v[i][2] + v[i][3]; }
#pragma unroll
        for (int sh = 1; sh < 64; sh <<= 1) s += __shfl_xor(s, sh);
        const float mu = s * (1.0f / 1024.0f); float q = 0.f;
#pragma unroll
        for (int i = 0; i < 4; ++i) { v[i] -= mu; q += v[i][0] * v[i][0] + v[i][1] * v[i][1] + v[i][2] * v[i][2] + v[i][3] * v[i][3]; }
#pragma unroll
        for (int sh = 1; sh < 64; sh <<= 1) q += __shfl_xor(q, sh);
        const float rs = rsqrtf(q * (1.0f / 1024.0f) + 1e-5f);
#pragma unroll
        for (int i = 0; i < 4; ++i) {
            const int c = 256 * i + 4 * lane;
            const f32x4 y = v[i] * rs * *(const f32x4*)(w + c) + *(const f32x4*)(bsh + c);
            *(f32x4*)(dstf + (size_t)row * 1024 + c) = y;
            if (dstb) { u32x2 o; o.x = cvt_pk_bf16(y[0], y[1]); o.y = cvt_pk_bf16(y[2], y[3]); *(u32x2*)(dstb + (size_t)row * 1024 + c) = o; }
        }
    }
}

__global__ void __launch_bounds__(512, 2) hybrid_fwd(Args a) {
    extern __shared__ __attribute__((aligned(16))) unsigned char lds_raw[];
    LAS unsigned char* lds = (LAS unsigned char*)lds_raw;
    unsigned char* ws = a.ws;
    pg8::StaticOrder S;
    for (int ph = a.ph_lo; ph < a.ph_hi; ++ph) {
        switch (ph) {
        case 0: prep_phase(lds, a); break;
        case 1: { pg8::Gemm g{(const bf16_t*)(ws + O_XB), (const bf16_t*)(ws + O_XB), (const bf16_t*)(ws + O_WIN), T_, 6144, 1024, 1024, 1 << 20};
            EpiProjA E{(bf16_t*)(ws + O_QF), (_Float16*)(ws + O_LF), (bf16_t*)(ws + O_VH), (bf16_t*)(ws + O_SG), (bf16_t*)a.out, (bf16_t*)a.out + (size_t)T_ * 1024, (const float*)(ws + O_LB), a.in[6]};
            S.init(T_, 6144, gridDim.x, blockIdx.x); pg8::gemm_phase(lds, g, S, E); } break;
        case 2: for (int it = blockIdx.x; it < 256; it += gridDim.x) if ((it & 7) != 7) hgrn_item<false>(lds, a, it); break;
        case 3: for (int it = blockIdx.x; it < 256; it += gridDim.x) hgrn_item<true>(lds, a, it); break;
        case 4: { pg8::Gemm g{(const bf16_t*)(ws + O_XB), (const bf16_t*)(ws + O_XB), (const bf16_t*)(ws + O_WIN) + (size_t)6144 * 1024, T_, 3072, 1024, 1024, 1 << 20};
            EpiProjB E{(bf16_t*)(ws + O_MQ), (bf16_t*)(ws + O_MK), (bf16_t*)(ws + O_MV), (float*)(ws + O_KM), (const float*)(ws + O_COS), (const float*)(ws + O_SIN)};
            S.init(T_, 3072, gridDim.x, blockIdx.x); pg8::gemm_phase(lds, g, S, E); } break;
        case 5: for (int pr = blockIdx.x; pr < 256; pr += gridDim.x) { const int bh = pr >> 3, jj = pr & 7; for (int k2 = 0; k2 < 2; ++k2) moba_item(lds, a, bh >> 3, bh & 7, k2 ? jj : 15 - jj); } break;
        case 6: { pg8::Gemm g{(const bf16_t*)(ws + O_YB), (const bf16_t*)(ws + O_YA), (const bf16_t*)(ws + O_WBR), T_, 1024, 2048, 1024, 16};
            EpiBranch E{(const bf16_t*)a.out, (const bf16_t*)a.out + (size_t)T_ * 1024, (bf16_t*)(ws + O_MM)};
            S.init(T_, 1024, gridDim.x, blockIdx.x); pg8::gemm_phase(lds, g, S, E); } break;
        case 7: { pg8::Gemm g{(const bf16_t*)(ws + O_MM), (const bf16_t*)(ws + O_MM), (const bf16_t*)(ws + O_WOUT), T_, 1024, 1024, 1024, 1 << 20};
            EpiRes E{a.in[0], (float*)(ws + O_R1)};
            S.init(T_, 1024, gridDim.x, blockIdx.x); pg8::gemm_phase(lds, g, S, E); } break;
        case 8: ln_phase((const float*)(ws + O_R1), a.in[8], a.in[9], a.out, (bf16_t*)(ws + O_X1B)); break;
        case 9: { pg8::Gemm g{(const bf16_t*)(ws + O_X1B), (const bf16_t*)(ws + O_X1B), (const bf16_t*)(ws + O_WFI), T_, 2 * DFF, 1024, 1024, 1 << 20};
            EpiFfnIn E{(bf16_t*)(ws + O_ACT)};
            S.init(T_, 2 * DFF, gridDim.x, blockIdx.x); pg8::gemm_phase(lds, g, S, E); } break;
        case 10: { pg8::Gemm g{(const bf16_t*)(ws + O_ACT), (const bf16_t*)(ws + O_ACT), (const bf16_t*)(ws + O_WFD), T_, 1024, DFF, DFF, 1 << 20};
            EpiRes E{a.out, (float*)(ws + O_R2)};
            S.init(T_, 1024, gridDim.x, blockIdx.x); pg8::gemm_phase(lds, g, S, E); } break;
        case 11: ln_phase((const float*)(ws + O_R2), a.in[12], a.in[13], a.out, nullptr); break;
        }
        if (ph + 1 < a.ph_hi) { cg::this_grid().sync(); }
    }
}

extern "C" void kernel_launch(void* const* d_in, const int* in_sizes, int n_in, void* d_out, int out_size, void* d_ws, size_t ws_size, hipStream_t stream) {
    static int grid = 0;
    if (grid == 0) {
        int dev = 0, cus = 0, per_cu = 0;
        hipGetDevice(&dev); hipDeviceGetAttribute(&cus, hipDeviceAttributeMultiprocessorCount, dev);
        hipFuncSetAttribute((const void*)hybrid_fwd, hipFuncAttributeMaxDynamicSharedMemorySize, LDS_BYTES);
        hipOccupancyMaxActiveBlocksPerMultiprocessor(&per_cu, (const void*)hybrid_fwd, 512, LDS_BYTES);
        if (per_cu < 1) { fprintf(stderr, "kernel_launch: occupancy query reports %d blocks per CU\n", per_cu); per_cu = 1; }
        if (per_cu > 1) per_cu = 1;
        grid = cus * per_cu;
        if (ws_size < 252 * MB) fprintf(stderr, "kernel_launch: workspace too small: %zu\n", ws_size);
    }
    Args a{};
    for (int i = 0; i < 14; ++i) a.in[i] = (const float*)d_in[i];
    a.out = (float*)d_out; a.ws = (unsigned char*)d_ws;
#if N_LAUNCH_MODE == 1
    a.ph_lo = 0; a.ph_hi = NPHASE;
    void* args[] = {&a};
    hipError_t e = hipLaunchCooperativeKernel((const void*)hybrid_fwd, dim3(grid), dim3(512), args, LDS_BYTES, stream);
    if (e != hipSuccess) fprintf(stderr, "cooperative launch failed: %s (grid %d)\n", hipGetErrorString(e), grid);
#else
    for (int ph = 0; ph < NPHASE; ++ph) { a.ph_lo = ph; a.ph_hi = ph + 1; hipLaunchKernelGGL(hybrid_fwd, dim3(grid), dim3(512), LDS_BYTES, stream, a); }
#endif
}
```

```cpp
#include <hip/hip_runtime.h>
#include <hip/hip_cooperative_groups.h>
#include <cstdio>
namespace cg = cooperative_groups;

#define LAS __attribute__((address_space(3)))
typedef unsigned short bf16_t;
typedef short bf16x8 __attribute__((ext_vector_type(8)));
typedef short s16x4 __attribute__((ext_vector_type(4)));
typedef float f32x4 __attribute__((ext_vector_type(4)));
typedef unsigned u32x4 __attribute__((ext_vector_type(4)));
typedef unsigned u32x2 __attribute__((ext_vector_type(2)));
typedef _Float16 h16x8 __attribute__((ext_vector_type(8)));

#ifndef N_LAUNCH_MODE
#define N_LAUNCH_MODE 1
#endif

constexpr int T_ = 16384, D_ = 1024, S_ = 4096, DFF = 2816;
constexpr float DN_ALPHA = 1.189207115002721f;
constexpr size_t MB = 1u << 20;
constexpr size_t O_XB = 0, O_MM = 0, O_WIN = 32 * MB, O_WBR = 50 * MB, O_WOUT = 54 * MB, O_WFI = 56 * MB, O_WFD = 67 * MB,
                 O_COS = 73 * MB, O_SIN = 74 * MB, O_KM = 75 * MB, O_LB = 75 * MB + 256 * 1024, O_GT = 75 * MB + 512 * 1024, O_SEG = 76 * MB,
                 O_QF = 92 * MB, O_LF = 124 * MB, O_VH = 156 * MB, O_SG = 188 * MB, O_YA = 220 * MB,
                 O_MQ = 92 * MB, O_MK = 124 * MB, O_MV = 156 * MB, O_YB = 188 * MB, O_R1 = 92 * MB, O_X1B = 220 * MB, O_ACT = 76 * MB, O_R2 = 164 * MB;
constexpr int LDS_BYTES = 131072 + 16;
constexpr size_t O_BAR = 75 * MB + 768 * 1024;
constexpr int NPHASE = 12;
#ifndef REPEAT_MASK
#define REPEAT_MASK 0
#endif

struct Args { const float* in[14]; float* out; unsigned char* ws; int ph_lo, ph_hi; };

__device__ __forceinline__ unsigned cvt_pk_bf16(float lo, float hi) { unsigned r; asm("v_cvt_pk_bf16_f32 %0, %1, %2" : "=v"(r) : "v"(lo), "v"(hi)); return r; }
__device__ __forceinline__ float bf2f(unsigned short b) { return __uint_as_float(((unsigned)b) << 16); }
__device__ __forceinline__ float bflo(unsigned w) { return __uint_as_float(w << 16); }
__device__ __forceinline__ float bfhi(unsigned w) { return __uint_as_float(w & 0xffff0000u); }
__device__ __forceinline__ float sigmoidf_(float x) { return __builtin_amdgcn_rcpf(1.0f + __expf(-x)); }
__device__ __forceinline__ float siluf_(float x) { return x * sigmoidf_(x); }
__device__ __forceinline__ u32x4 pack8(const f32x4& a, const f32x4& b) { u32x4 w; w.x = cvt_pk_bf16(a[0], a[1]); w.y = cvt_pk_bf16(a[2], a[3]); w.z = cvt_pk_bf16(b[0], b[1]); w.w = cvt_pk_bf16(b[2], b[3]); return w; }

namespace pg8 {
constexpr int BM = 256, BK = 64, HALF = 128, HTB = HALF * BK * 2, STAGE_BYTES = 8 * HTB, NXCD = 8, WGM = 8;
__device__ __forceinline__ int lds_byte(int r, int c) { const int st = (r >> 4) * 2 + (c >> 5), rr = r & 15, cc = c & 31, ob = rr * 64 + cc * 2; return st * 1024 + (ob ^ (((ob >> 9) & 1) << 5)); }
__device__ __forceinline__ void stage_rc(int b, int& R, int& C) { const int st = b / 1024, sb = b % 1024, swz = sb ^ (((sb >> 9) & 1) << 5); R = (st >> 1) * 16 + swz / 64; C = (st & 1) * 32 + (swz % 64) / 2; }
__device__ __forceinline__ int perm32(int rho) { const int n = rho >> 4, i = rho & 15; return 8 * (i >> 2) + 4 * n + (i & 3); }
struct Unit { int pm, pn; };
struct Gemm { const bf16_t* A; const bf16_t* A2; const bf16_t* Bt; int M, N, K, lda, ksplit; };
struct StaticOrder {
    int nM, nN, nwg, G, c;
    __device__ void init(int M, int N, int G_, int c_) { nM = M / BM; nN = N / BM; nwg = nM * nN; G = G_; c = c_; }
    __device__ bool next(int i, Unit& u) const {
        const long L = (long)i * G + c; if (L >= nwg) return false;
        int wgid = (int)L; { const int q = nwg / NXCD, r = nwg % NXCD, xcd = wgid % NXCD, off = wgid / NXCD; wgid = (xcd < r ? xcd * (q + 1) : r * (q + 1) + (xcd - r) * q) + off; }
        const int nig = WGM * nN, gid = wgid / nig, fm = gid * WGM, gsz = (nM - fm) < WGM ? (nM - fm) : WGM;
        u.pm = fm + ((wgid % nig) % gsz); u.pn = (wgid % nig) / gsz; return true;
    }
};
template <class Epi>
__device__ __forceinline__ void gemm_phase(LAS unsigned char* lds, const Gemm g, const StaticOrder& S, const Epi& E) {
    int tid_ = threadIdx.x; asm volatile("" : "+v"(tid_));
    const int tid = tid_, wid = __builtin_amdgcn_readfirstlane(tid >> 6), lane = tid & 63, wr = wid >> 2, wc = wid & 3, fr = lane & 15, fq = lane >> 4;
    const int K = g.K, nt = K / BK, ks = g.ksplit;
    unsigned voffA[2], voffB[2];
#pragma unroll
    for (int i = 0; i < 2; ++i) { int R, C; stage_rc(tid * 16 + i * 8192, R, C); const int Rb = (R & ~31) + perm32(R & 31);
        voffA[i] = (unsigned)(R * g.lda + C) * 2u; voffB[i] = (unsigned)(Rb * K + C) * 2u; }
    const size_t kstep = (size_t)(BK * 2);
    const size_t hstepA = (size_t)HALF * g.lda * 2, hstepB = (size_t)HALF * K * 2;
    const size_t tstepA = 2 * hstepA, tstepB = 2 * hstepB;
    const unsigned ldsw = (unsigned)wid * 1024u;
    const int aoff = lds_byte(wr * 64 + fr, fq * 8), boff = lds_byte(wc * 32 + fr, fq * 8);
#define PG8_SA(b, h) (((b) * 2 + (h)) * HTB)
#define PG8_SB(b, h) ((4 + (b) * 2 + (h)) * HTB)
#define PG8_STAGE(bufoff, gbase, voff) do { _Pragma("unroll") for (int _i = 0; _i < 2; ++_i) \
        __builtin_amdgcn_global_load_lds((const unsigned*)((const char*)(gbase) + (voff)[_i]), (LAS unsigned*)(lds + (bufoff) + ldsw + _i * 8192), 16, 0, 0); } while (0)
#define PG8_LDA(dst, b, h) do { _Pragma("unroll") for (int m = 0; m < 4; ++m) _Pragma("unroll") for (int k = 0; k < 2; ++k) dst[m][k] = *(const LAS bf16x8*)(lds + PG8_SA(b, h) + aoff + m * 2048 + k * 1024); } while (0)
#define PG8_LDB(dst, b, h) do { _Pragma("unroll") for (int n = 0; n < 2; ++n) _Pragma("unroll") for (int k = 0; k < 2; ++k) dst[n][k] = *(const LAS bf16x8*)(lds + PG8_SB(b, h) + boff + n * 2048 + k * 1024); } while (0)
#define PG8_MMA(ai, bj, At, Bt) do { __builtin_amdgcn_s_setprio(1); _Pragma("unroll") for (int m = 0; m < 4; ++m) _Pragma("unroll") for (int n = 0; n < 2; ++n) _Pragma("unroll") for (int k = 0; k < 2; ++k) \
        acc[ai][bj][m][n] = __builtin_amdgcn_mfma_f32_16x16x32_bf16(Bt[n][k], At[m][k], acc[ai][bj][m][n], 0, 0, 0); __builtin_amdgcn_s_setprio(0); } while (0)
#define PG8_WAIT_V(n) asm volatile("s_waitcnt vmcnt(" #n ")" ::: "memory")
#define PG8_WAIT_L(n) asm volatile("s_waitcnt lgkmcnt(" #n ")" ::: "memory")
#define PG8_BAR __builtin_amdgcn_s_barrier()
#define PG8_SCHED __builtin_amdgcn_sched_barrier(0)
    Unit cur, nxt; int ui = 0;
    if (!S.next(0, cur)) return;
    f32x4 acc[2][2][4][2];
#pragma unroll
    for (int a = 0; a < 2; ++a)
#pragma unroll
        for (int b = 0; b < 2; ++b)
#pragma unroll
            for (int m = 0; m < 4; ++m)
#pragma unroll
                for (int n = 0; n < 2; ++n) acc[a][b][m][n] = (f32x4){0.f, 0.f, 0.f, 0.f};
    bf16x8 At[4][2], B0[2][2], B1[2][2];
    const char* cA = (const char*)g.A + (size_t)cur.pm * tstepA; const char* cA2 = (const char*)g.A2 + (size_t)cur.pm * tstepA - (size_t)ks * kstep;
    const char* cB = (const char*)g.Bt + (size_t)cur.pn * tstepB;
    PG8_STAGE(PG8_SB(0, 0), cB, voffB); PG8_STAGE(PG8_SA(0, 0), cA, voffA); PG8_STAGE(PG8_SB(0, 1), cB + hstepB, voffB); PG8_STAGE(PG8_SA(0, 1), cA + hstepA, voffA);
    if (wr == 1) PG8_BAR;
    PG8_WAIT_V(4); PG8_BAR;
    PG8_STAGE(PG8_SB(1, 0), cB + kstep, voffB); PG8_STAGE(PG8_SA(1, 0), cA + kstep, voffA); PG8_STAGE(PG8_SB(1, 1), cB + hstepB + kstep, voffB);
    PG8_WAIT_V(6); PG8_BAR;
    for (;;) {
        const bool has_next = S.next(ui + 1, nxt);
        const char* nA = has_next ? (const char*)g.A + (size_t)nxt.pm * tstepA : cA; const char* nB = has_next ? (const char*)g.Bt + (size_t)nxt.pn * tstepB : cB;
        for (int t = 0; t < nt; t += 2) {
            const bool last = (t == nt - 2);
            if constexpr (Epi::HAS_MID) { if (t == ks) E.mid(acc, cur, wr, wc, fr, fq); }
            const char* a1 = ((t + 1) < ks ? cA : cA2) + (size_t)(t + 1) * kstep;
            const char* a2 = last ? nA : ((t + 2) < ks ? cA : cA2) + (size_t)(t + 2) * kstep; const char* b2 = last ? nB : cB + (size_t)(t + 2) * kstep;
            const char* a3 = a2 + kstep; const char* b3 = b2 + kstep;
            PG8_LDB(B0, 0, 0); PG8_SCHED; PG8_LDA(At, 0, 0); PG8_STAGE(PG8_SA(1, 1), a1 + hstepA, voffA);
            PG8_WAIT_L(8); PG8_BAR; PG8_WAIT_L(0); PG8_MMA(0, 0, At, B0); PG8_BAR; PG8_SCHED;
            PG8_LDB(B1, 0, 1); PG8_STAGE(PG8_SB(0, 0), b2, voffB);
            PG8_BAR; PG8_WAIT_L(0); PG8_MMA(0, 1, At, B1); PG8_BAR;
            PG8_LDA(At, 0, 1); PG8_STAGE(PG8_SA(0, 0), a2, voffA);
            PG8_BAR; PG8_WAIT_L(0); PG8_MMA(1, 0, At, B0); PG8_BAR; PG8_SCHED;
            PG8_STAGE(PG8_SB(0, 1), b2 + hstepB, voffB);
            PG8_WAIT_V(6); PG8_BAR; PG8_MMA(1, 1, At, B1); PG8_BAR;
            PG8_LDB(B0, 1, 0); PG8_SCHED; PG8_LDA(At, 1, 0); PG8_STAGE(PG8_SA(0, 1), a2 + hstepA, voffA);
            PG8_WAIT_L(8); PG8_BAR; PG8_WAIT_L(0); PG8_MMA(0, 0, At, B0); PG8_BAR; PG8_SCHED;
            PG8_LDB(B1, 1, 1); PG8_STAGE(PG8_SB(1, 0), b3, voffB);
            PG8_BAR; PG8_WAIT_L(0); PG8_MMA(0, 1, At, B1); PG8_BAR;
            PG8_LDA(At, 1, 1); PG8_STAGE(PG8_SA(1, 0), a3, voffA);
            PG8_BAR; PG8_WAIT_L(0); PG8_MMA(1, 0, At, B0); PG8_BAR; PG8_SCHED;
            PG8_STAGE(PG8_SB(1, 1), b3 + hstepB, voffB);
            PG8_WAIT_V(6); PG8_BAR; PG8_MMA(1, 1, At, B1); PG8_BAR;
        }
        E(acc, cur, wr, wc, fr, fq);
        if (!has_next) break;
#pragma unroll
        for (int a = 0; a < 2; ++a)
#pragma unroll
            for (int b = 0; b < 2; ++b)
#pragma unroll
                for (int m = 0; m < 4; ++m)
#pragma unroll
                    for (int n = 0; n < 2; ++n) acc[a][b][m][n] = (f32x4){0.f, 0.f, 0.f, 0.f};
        cur = nxt; cA = nA; cA2 = (const char*)g.A2 + (size_t)cur.pm * tstepA - (size_t)ks * kstep; cB = nB; ++ui;
    }
    PG8_WAIT_V(0);
    if (wr == 0) PG8_BAR;
    PG8_BAR;
#undef PG8_SA
#undef PG8_SB
#undef PG8_STAGE
#undef PG8_LDA
#undef PG8_LDB
#undef PG8_MMA
#undef PG8_WAIT_V
#undef PG8_WAIT_L
#undef PG8_BAR
#undef PG8_SCHED
}
}
using pg8::Unit;
typedef f32x4 Acc[2][2][4][2];

struct EpiProjA {
    static constexpr bool HAS_MID = false;
    bf16_t* QF; _Float16* LF; bf16_t* VH; bf16_t* SG; bf16_t* GA; bf16_t* GR; const float* lb; const float* bg;
    __device__ __forceinline__ void mid(Acc&, const Unit&, int, int, int, int) const {}
    __device__ __forceinline__ void operator()(const Acc& acc, const Unit& u, int wr, int wc, int fr, int fq) const {
        const int row0 = u.pm * 256 + wr * 64 + fr, seg = u.pn >> 2;
        if (seg < 4) {
            const int cs0 = (u.pn & 3) * 256 + wc * 32 + 8 * fq;
#pragma unroll
            for (int bj = 0; bj < 2; ++bj) {
                const int cs = cs0 + bj * 128;
                f32x4 l0 = {0.f, 0.f, 0.f, 0.f}, l1 = l0;
                if (seg == 1) { l0 = *(const f32x4*)(lb + cs); l1 = *(const f32x4*)(lb + cs + 4); }
#pragma unroll
                for (int ai = 0; ai < 2; ++ai)
#pragma unroll
                    for (int m = 0; m < 4; ++m) {
                        const size_t off = (size_t)(row0 + ai * 128 + m * 16) * 1024 + cs;
                        f32x4 v0 = acc[ai][bj][m][0], v1 = acc[ai][bj][m][1];
                        if (seg == 1) {
                            h16x8 hv;
#pragma unroll
                            for (int j = 0; j < 4; ++j) { hv[j] = (_Float16)__logf(l0[j] + (1.0f - l0[j]) * sigmoidf_(v0[j])); hv[4 + j] = (_Float16)__logf(l1[j] + (1.0f - l1[j]) * sigmoidf_(v1[j])); }
                            *(h16x8*)(LF + off) = hv;
                        } else {
                            if (seg == 0 || seg == 3) {
#pragma unroll
                                for (int j = 0; j < 4; ++j) { v0[j] = siluf_(v0[j]); v1[j] = siluf_(v1[j]); } }
                            const u32x4 pk = pack8(v0, v1);
                            if (seg == 0) *(u32x4*)(QF + off) = pk; else if (seg == 2) *(u32x4*)(VH + off) = pk; else *(u32x4*)(SG + off) = pk;
                        }
                        __builtin_amdgcn_sched_barrier(0);
                    }
            }
        } else {
            const int c = (u.pn - 16) * 128 + wc * 32 + 8 * fq;
            const f32x4 ba0 = *(const f32x4*)(bg + c), ba1 = *(const f32x4*)(bg + c + 4), bb0 = *(const f32x4*)(bg + 1024 + c), bb1 = *(const f32x4*)(bg + 1024 + c + 4);
#pragma unroll
            for (int ai = 0; ai < 2; ++ai)
#pragma unroll
                for (int m = 0; m < 4; ++m) {
                    const size_t off = (size_t)(row0 + ai * 128 + m * 16) * 1024 + c;
                    f32x4 a0, a1, r0, r1;
#pragma unroll
                    for (int j = 0; j < 4; ++j) {
                        a0[j] = sigmoidf_(acc[ai][0][m][0][j] + ba0[j]); a1[j] = sigmoidf_(acc[ai][0][m][1][j] + ba1[j]);
                        r0[j] = sigmoidf_(acc[ai][1][m][0][j] + bb0[j]) / a0[j]; r1[j] = sigmoidf_(acc[ai][1][m][1][j] + bb1[j]) / a1[j]; }
                    *(u32x4*)(GA + off) = pack8(a0, a1); *(u32x4*)(GR + off) = pack8(r0, r1); __builtin_amdgcn_sched_barrier(0);
                }
        }
    }
};
struct EpiProjB {
    static constexpr bool HAS_MID = false;
    bf16_t* MQ; bf16_t* MK; bf16_t* MV; float* KM; const float* COS; const float* SIN;
    __device__ __forceinline__ void mid(Acc&, const Unit&, int, int, int, int) const {}
    __device__ __forceinline__ void operator()(const Acc& acc, const Unit& u, int wr, int wc, int fr, int fq) const {
        const int row0 = u.pm * 256 + wr * 64 + fr, seg = u.pn >> 2;
        if (seg == 2) {
            const int cs0 = (u.pn & 3) * 256 + wc * 32 + 8 * fq;
#pragma unroll
            for (int bj = 0; bj < 2; ++bj)
#pragma unroll
                for (int ai = 0; ai < 2; ++ai)
#pragma unroll
                    for (int m = 0; m < 4; ++m)
                        *(u32x4*)(MV + (size_t)(row0 + ai * 128 + m * 16) * 1024 + cs0 + bj * 128) = pack8(acc[ai][bj][m][0], acc[ai][bj][m][1]);
        } else {
            const int head = 2 * (u.pn & 3) + (wc >> 1), i0 = 32 * (wc & 1) + 8 * fq;
            const float sc = seg == 0 ? 0.08838834764831845f * 1.4426950408889634f : 1.0f;
            f32x4 s1a = {0.f, 0.f, 0.f, 0.f}, s1b = s1a, s2a = s1a, s2b = s1a;
#pragma unroll
            for (int ai = 0; ai < 2; ++ai)
#pragma unroll
                for (int m = 0; m < 4; ++m) {
                    const int row = row0 + ai * 128 + m * 16, pos = row & (S_ - 1);
                    const f32x4 c0 = *(const f32x4*)(COS + pos * 64 + i0), c1 = *(const f32x4*)(COS + pos * 64 + i0 + 4);
                    const f32x4 n0 = *(const f32x4*)(SIN + pos * 64 + i0), n1 = *(const f32x4*)(SIN + pos * 64 + i0 + 4);
                    const f32x4 x1a = acc[ai][0][m][0], x1b = acc[ai][0][m][1], x2a = acc[ai][1][m][0], x2b = acc[ai][1][m][1];
                    f32x4 o1a = (x1a * c0 - x2a * n0) * sc, o1b = (x1b * c1 - x2b * n1) * sc, o2a = (x2a * c0 + x1a * n0) * sc, o2b = (x2b * c1 + x1b * n1) * sc;
                    const size_t off = (size_t)row * 1024 + head * 128 + i0;
                    if (seg == 0) { *(u32x4*)(MQ + off) = pack8(o1a, o1b); *(u32x4*)(MQ + off + 64) = pack8(o2a, o2b); }
                    else { *(u32x4*)(MK + off) = pack8(o1a, o1b); *(u32x4*)(MK + off + 64) = pack8(o2a, o2b); }
                    s1a += o1a; s1b += o1b; s2a += o2a; s2b += o2b;
                    asm volatile("" : "+v"(s1a), "+v"(s1b), "+v"(s2a), "+v"(s2b));
                    __builtin_amdgcn_sched_barrier(0);
                }
            if (seg == 1) {
#pragma unroll
                for (int sh = 1; sh < 16; sh <<= 1)
#pragma unroll
                    for (int j = 0; j < 4; ++j) { s1a[j] += __shfl_xor(s1a[j], sh); s1b[j] += __shfl_xor(s1b[j], sh); s2a[j] += __shfl_xor(s2a[j], sh); s2b[j] += __shfl_xor(s2b[j], sh); }
                if (fr == 0) {
                    float* km = KM + ((size_t)((u.pm >> 4) * 8 + head) * 16 + (u.pm & 15)) * 128 + i0;
#pragma unroll
                    for (int j = 0; j < 4; ++j) { atomicAdd(km + j, s1a[j] * (1.0f / 256.0f)); atomicAdd(km + 4 + j, s1b[j] * (1.0f / 256.0f)); atomicAdd(km + 64 + j, s2a[j] * (1.0f / 256.0f)); atomicAdd(km + 68 + j, s2b[j] * (1.0f / 256.0f)); }
                }
            }
        }
    }
};
struct EpiBranch {
    static constexpr bool HAS_MID = true;
    const bf16_t* GA; const bf16_t* GR; bf16_t* MM;
    __device__ __forceinline__ void mid(Acc& acc, const Unit& u, int wr, int wc, int fr, int fq) const {
        int row0 = u.pm * 256 + wr * 64 + fr; const int c0 = u.pn * 256 + wc * 32 + 8 * fq;
        asm volatile("" : "+v"(row0));
#pragma unroll
        for (int ai = 0; ai < 2; ++ai)
#pragma unroll
            for (int m = 0; m < 4; ++m)
#pragma unroll
                for (int bj = 0; bj < 2; ++bj) {
                    const u32x4 w = *(const u32x4*)(GR + (size_t)(row0 + ai * 128 + m * 16) * 1024 + c0 + bj * 128);
                    acc[ai][bj][m][0] *= (f32x4){bflo(w.x), bfhi(w.x), bflo(w.y), bfhi(w.y)}; acc[ai][bj][m][1] *= (f32x4){bflo(w.z), bfhi(w.z), bflo(w.w), bfhi(w.w)}; __builtin_amdgcn_sched_barrier(0);
                }
    }
    __device__ __forceinline__ void operator()(const Acc& acc, const Unit& u, int wr, int wc, int fr, int fq) const {
        const int row0 = u.pm * 256 + wr * 64 + fr, c0 = u.pn * 256 + wc * 32 + 8 * fq;
#pragma unroll
        for (int ai = 0; ai < 2; ++ai)
#pragma unroll
            for (int m = 0; m < 4; ++m)
#pragma unroll
                for (int bj = 0; bj < 2; ++bj) {
                    const size_t off = (size_t)(row0 + ai * 128 + m * 16) * 1024 + c0 + bj * 128;
                    const u32x4 w = *(const u32x4*)(GA + off);
                    *(u32x4*)(MM + off) = pack8(acc[ai][bj][m][0] * (f32x4){bflo(w.x), bfhi(w.x), bflo(w.y), bfhi(w.y)}, acc[ai][bj][m][1] * (f32x4){bflo(w.z), bfhi(w.z), bflo(w.w), bfhi(w.w)}); __builtin_amdgcn_sched_barrier(0);
                }
    }
};
struct EpiRes {
    static constexpr bool HAS_MID = false;
    const float* res; float* dst;
    __device__ __forceinline__ void mid(Acc&, const Unit&, int, int, int, int) const {}
    __device__ __forceinline__ void operator()(const Acc& acc, const Unit& u, int wr, int wc, int fr, int fq) const {
        const int row0 = u.pm * 256 + wr * 64 + fr, c0 = u.pn * 256 + wc * 32 + 8 * fq;
#pragma unroll
        for (int ai = 0; ai < 2; ++ai)
#pragma unroll
            for (int m = 0; m < 4; ++m)
#pragma unroll
                for (int bj = 0; bj < 2; ++bj) {
                    const size_t off = (size_t)(row0 + ai * 128 + m * 16) * 1024 + c0 + bj * 128;
                    const f32x4 r0 = *(const f32x4*)(res + off), r1 = *(const f32x4*)(res + off + 4);
                    *(f32x4*)(dst + off) = r0 * DN_ALPHA + acc[ai][bj][m][0]; *(f32x4*)(dst + off + 4) = r1 * DN_ALPHA + acc[ai][bj][m][1]; __builtin_amdgcn_sched_barrier(0);
                }
    }
};
struct EpiFfnIn {
    static constexpr bool HAS_MID = false;
    bf16_t* ACT;
    __device__ __forceinline__ void mid(Acc&, const Unit&, int, int, int, int) const {}
    __device__ __forceinline__ void operator()(const Acc& acc, const Unit& u, int wr, int wc, int fr, int fq) const {
        const int row0 = u.pm * 256 + wr * 64 + fr, c0 = u.pn * 128 + wc * 32 + 8 * fq;
#pragma unroll
        for (int ai = 0; ai < 2; ++ai)
#pragma unroll
            for (int m = 0; m < 4; ++m) {
                f32x4 a0, a1;
#pragma unroll
                for (int j = 0; j < 4; ++j) { a0[j] = siluf_(acc[ai][0][m][0][j]) * acc[ai][1][m][0][j]; a1[j] = siluf_(acc[ai][0][m][1][j]) * acc[ai][1][m][1][j]; }
                *(u32x4*)(ACT + (size_t)(row0 + ai * 128 + m * 16) * DFF + c0) = pack8(a0, a1);
            }
    }
};

__device__ __forceinline__ int perm_in(int n) {
    if (n < 4096) return n;
    if (n < 6144) { const int q = (n - 4096) >> 8, tc = n & 255; return 7168 + 1024 * (tc >> 7) + 128 * q + (tc & 127); }
    if (n < 8192) { const int u = n - 6144, seg = u >> 10, q = (u & 1023) >> 8, tc = u & 255, bj = tc >> 7, hh = (tc & 127) >> 6, i = tc & 63; return 4096 + 1024 * seg + 128 * (2 * q + hh) + 64 * bj + i; }
    return 6144 + (n - 8192);
}
__device__ __forceinline__ int perm_ffi(int n) { const int pn = n >> 8, tc = n & 255; return DFF * (tc >> 7) + 128 * pn + (tc & 127); }

__device__ __forceinline__ void prep_phase(LAS unsigned char* lds, const Args& a) {
    int tid_ = threadIdx.x; asm volatile("" : "+v"(tid_));
    const int tid = tid_, nb = gridDim.x, bid = blockIdx.x;
    unsigned char* ws = a.ws;
    {   const float4* x4 = (const float4*)a.in[0]; u32x2* xb = (u32x2*)(ws + O_XB); const size_t n4 = (size_t)T_ * D_ / 4;
        for (size_t i = (size_t)bid * 512 + tid; i < n4; i += (size_t)nb * 512) { const float4 v = x4[i]; u32x2 w; w.x = cvt_pk_bf16(v.x, v.y); w.y = cvt_pk_bf16(v.z, v.w); xb[i] = w; } }
    {   float* COS = (float*)(ws + O_COS); float* SIN = (float*)(ws + O_SIN);
        for (int i = bid * 512 + tid; i < S_ * 64; i += nb * 512) {
            const int pos = i >> 6, f = i & 63;
            const float inv = exp2f(-(float)f * (13.287712379549449f / 64.0f));
            const float angf = (float)pos * inv;
            const double ang = (double)angf;
            const double j = rint(ang * 0.6366197723675814); const float r = (float)(ang - j * 1.5707963267948966); const float r2 = r * r;
            const float sn = r * (1.0f + r2 * (-1.6666667e-1f + r2 * (8.3333333e-3f + r2 * (-1.9841270e-4f + r2 * (2.7557319e-6f + r2 * (-2.5052108e-8f))))));
            const float cs = 1.0f + r2 * (-0.5f + r2 * (4.1666667e-2f + r2 * (-1.3888889e-3f + r2 * (2.4801587e-5f + r2 * (-2.7557319e-7f + r2 * 2.0876757e-9f)))));
            const int q = ((int)j) & 3;
            const float s = (q == 0) ? sn : (q == 1) ? cs : (q == 2) ? -sn : -cs;
            const float c = (q == 0) ? cs : (q == 1) ? -sn : (q == 2) ? -cs : sn;
            COS[i] = c; SIN[i] = s;
        }
        float* KM = (float*)(ws + O_KM);
        for (int i = bid * 512 + tid; i < 4 * 8 * 16 * 128; i += nb * 512) KM[i] = 0.f;
        float* LB = (float*)(ws + O_LB); const float* lbl = a.in[2];
        for (int i = bid * 512 + tid; i < 1024; i += nb * 512) LB[i] = 1.0f / (1.0f + expf(lbl[1024 + i] - lbl[i]));
    }
    LAS float* tl = (LAS float*)lds;
    for (int ti = bid; ti < 5184; ti += nb) {
        const float* src; bf16_t* dst; int nsrc, ldd, koff, ntn, mode, loc;
        if (ti < 2304) { src = a.in[1]; dst = (bf16_t*)(ws + O_WIN); nsrc = 9216; ldd = 1024; koff = 0; ntn = 144; mode = 1; loc = ti; }
        else if (ti < 2560) { src = a.in[5]; dst = (bf16_t*)(ws + O_WBR); nsrc = 1024; ldd = 2048; koff = 0; ntn = 16; mode = 0; loc = ti - 2304; }
        else if (ti < 2816) { src = a.in[4]; dst = (bf16_t*)(ws + O_WBR); nsrc = 1024; ldd = 2048; koff = 1024; ntn = 16; mode = 0; loc = ti - 2560; }
        else if (ti < 3072) { src = a.in[7]; dst = (bf16_t*)(ws + O_WOUT); nsrc = 1024; ldd = 1024; koff = 0; ntn = 16; mode = 0; loc = ti - 2816; }
        else if (ti < 4480) { src = a.in[10]; dst = (bf16_t*)(ws + O_WFI); nsrc = 5632; ldd = 1024; koff = 0; ntn = 88; mode = 2; loc = ti - 3072; }
        else { src = a.in[11]; dst = (bf16_t*)(ws + O_WFD); nsrc = 1024; ldd = 2816; koff = 0; ntn = 16; mode = 0; loc = ti - 4480; }
        const int n0 = (loc % ntn) * 64, k0 = (loc / ntn) * 64;
        {   const int nn = tid & 63, kk0 = tid >> 6; const int n = n0 + nn; const int on = mode == 1 ? perm_in(n) : (mode == 2 ? perm_ffi(n) : n);
#pragma unroll
            for (int i = 0; i < 8; ++i) { const int kk = kk0 + 8 * i; tl[kk * 65 + nn] = src[(size_t)(k0 + kk) * nsrc + on]; } }
        __syncthreads();
        {   const int nn = tid >> 3, kc = tid & 7; float v[8];
#pragma unroll
            for (int e = 0; e < 8; ++e) v[e] = tl[(8 * kc + e) * 65 + nn];
            u32x4 w; w.x = cvt_pk_bf16(v[0], v[1]); w.y = cvt_pk_bf16(v[2], v[3]); w.z = cvt_pk_bf16(v[4], v[5]); w.w = cvt_pk_bf16(v[6], v[7]);
            *(u32x4*)(dst + (size_t)(n0 + nn) * ldd + koff + k0 + 8 * kc) = w; }
        __syncthreads();
    }
}

constexpr int HQ = 0, HK = 17408, HKT = 34816, HVT = 53248, HP = 71680, HST = 80896, HEG = 115712, HGS = 116224, HRS = 118272;
__device__ __forceinline__ f32x4 mfma16(bf16x8 a, bf16x8 b, f32x4 c) { return __builtin_amdgcn_mfma_f32_16x16x32_bf16(a, b, c, 0, 0, 0); }
template <bool FULL>
__device__ __forceinline__ void hgrn_item(LAS unsigned char* lds, const Args& a, int item) {
    unsigned char* ws = a.ws;
    int tid_ = threadIdx.x; asm volatile("" : "+v"(tid_));
    const int tid = tid_, wid = tid >> 6, lane = tid & 63, fr = lane & 15, g = lane >> 4;
    const int b = item >> 6, h = (item >> 3) & 7, seg = item & 7;
    const int tok0 = b * S_ + seg * 512, col0 = h * 128;
    const bf16_t* QF = (const bf16_t*)(ws + O_QF); const _Float16* LF = (const _Float16*)(ws + O_LF); const bf16_t* VH = (const bf16_t*)(ws + O_VH); const bf16_t* SG = (const bf16_t*)(ws + O_SG);
    bf16_t* YA = (bf16_t*)(ws + O_YA); float* SEG = (float*)(ws + O_SEG); float* GT = (float*)(ws + O_GT);
    LAS float* EG = (LAS float*)(lds + HEG); LAS float* GS = (LAS float*)(lds + HGS); LAS float* RS = (LAS float*)(lds + HRS);
    f32x4 st[8];
#pragma unroll
    for (int vt = 0; vt < 8; ++vt) st[vt] = (f32x4){0.f, 0.f, 0.f, 0.f};
    if (FULL) {
        for (int i = 0; i < seg; ++i) {
            const int it = item - seg + i;
            const float* sp = SEG + (size_t)it * 16384; const float* gp = GT + it * 128;
            float e[4];
#pragma unroll
            for (int r = 0; r < 4; ++r) e[r] = __expf(gp[16 * wid + 4 * g + r]);
#pragma unroll
            for (int vt = 0; vt < 8; ++vt)
#pragma unroll
                for (int r = 0; r < 4; ++r) st[vt][r] = e[r] * st[vt][r] + sp[(16 * wid + 4 * g + r) * 128 + 16 * vt + fr];
        }
    }
    const int d = tid & 127, tg = tid >> 7;
    float gsum = 0.f;
    for (int c = 0; c < 8; ++c) {
        const int t0 = tok0 + 64 * c;
        const size_t gb = (size_t)(t0 + 16 * tg) * 1024 + col0 + d;
        float lf[16], G[16];
        unsigned short vv[16], qq[16];
#pragma unroll
        for (int j = 0; j < 16; ++j) { lf[j] = (float)LF[gb + (size_t)j * 1024]; vv[j] = VH[gb + (size_t)j * 1024]; if (FULL) qq[j] = QF[gb + (size_t)j * 1024]; }
        float run = 0.f;
#pragma unroll
        for (int j = 0; j < 16; ++j) { run += lf[j]; G[j] = run; }
        GS[tg * 128 + d] = run;
        __syncthreads();
        const float g0 = GS[d], g1 = GS[128 + d], g2 = GS[256 + d], g3 = GS[384 + d];
        const float pre = tg == 0 ? 0.f : (tg == 1 ? g0 : (tg == 2 ? g0 + g1 : g0 + g1 + g2));
        const float glast = g0 + g1 + g2 + g3;
        if (tg == 0) EG[d] = __expf(glast);
        gsum += glast;
        {
            unsigned kp[8], vp[8];
#pragma unroll
            for (int j = 0; j < 16; j += 2) {
                const float G0 = G[j] + pre, G1 = G[j + 1] + pre;
                const float k0 = (1.0f - __expf(lf[j])) * __expf(-G0), k1 = (1.0f - __expf(lf[j + 1])) * __expf(-G1);
                const unsigned kw = cvt_pk_bf16(k0, k1);
                kp[j >> 1] = kw; vp[j >> 1] = (unsigned)vv[j] | ((unsigned)vv[j + 1] << 16);
                if (FULL) {
                    const unsigned qw = cvt_pk_bf16(bf2f(qq[j]) * __expf(G0), bf2f(qq[j + 1]) * __expf(G1));
                    *(LAS unsigned short*)(lds + HK + (16 * tg + j) * 272 + d * 2) = (unsigned short)(kw & 0xffff);
                    *(LAS unsigned short*)(lds + HK + (16 * tg + j + 1) * 272 + d * 2) = (unsigned short)(kw >> 16);
                    *(LAS unsigned short*)(lds + HQ + (16 * tg + j) * 272 + d * 2) = (unsigned short)(qw & 0xffff);
                    *(LAS unsigned short*)(lds + HQ + (16 * tg + j + 1) * 272 + d * 2) = (unsigned short)(qw >> 16);
                }
            }
            *(LAS u32x4*)(lds + HKT + d * 144 + tg * 32) = (u32x4){kp[0], kp[1], kp[2], kp[3]}; *(LAS u32x4*)(lds + HKT + d * 144 + tg * 32 + 16) = (u32x4){kp[4], kp[5], kp[6], kp[7]};
            *(LAS u32x4*)(lds + HVT + d * 144 + tg * 32) = (u32x4){vp[0], vp[1], vp[2], vp[3]}; *(LAS u32x4*)(lds + HVT + d * 144 + tg * 32 + 16) = (u32x4){vp[4], vp[5], vp[6], vp[7]};
        }
        if (FULL) {
#pragma unroll
            for (int vt = 0; vt < 8; ++vt) { u32x2 w; w.x = cvt_pk_bf16(st[vt][0], st[vt][1]); w.y = cvt_pk_bf16(st[vt][2], st[vt][3]);
                *(LAS u32x2*)(lds + HST + (16 * vt + fr) * 272 + (16 * wid + 4 * g) * 2) = w; }
        }
        __syncthreads();
        if (FULL) {
#pragma unroll
            for (int q = 0; q < 2; ++q) {
                const int idx = 2 * wid + q, stl = idx >> 2, ttl = idx & 3;
                f32x4 sc = {0.f, 0.f, 0.f, 0.f};
                if (stl <= ttl) {
#pragma unroll
                    for (int kk = 0; kk < 4; ++kk) {
                        const bf16x8 ka = *(const LAS bf16x8*)(lds + HK + (16 * stl + fr) * 272 + (32 * kk + 8 * g) * 2);
                        const bf16x8 qb = *(const LAS bf16x8*)(lds + HQ + (16 * ttl + fr) * 272 + (32 * kk + 8 * g) * 2);
                        sc = mfma16(ka, qb, sc);
                    }
                }
                const int tq = 16 * ttl + fr, s0 = 16 * stl + 4 * g;
                u32x2 w; w.x = cvt_pk_bf16(s0 <= tq ? sc[0] : 0.f, s0 + 1 <= tq ? sc[1] : 0.f); w.y = cvt_pk_bf16(s0 + 2 <= tq ? sc[2] : 0.f, s0 + 3 <= tq ? sc[3] : 0.f);
                *(LAS u32x2*)(lds + HP + tq * 144 + s0 * 2) = w;
            }
        }
        f32x4 oacc[4];
        if (FULL) {
            const int ttl = wid & 3;
#pragma unroll
            for (int i = 0; i < 4; ++i) {
                const int vt = 4 * (wid >> 2) + i; f32x4 o = {0.f, 0.f, 0.f, 0.f};
#pragma unroll
                for (int kk = 0; kk < 4; ++kk) {
                    const bf16x8 sa = *(const LAS bf16x8*)(lds + HST + (16 * vt + fr) * 272 + (32 * kk + 8 * g) * 2);
                    const bf16x8 qb = *(const LAS bf16x8*)(lds + HQ + (16 * ttl + fr) * 272 + (32 * kk + 8 * g) * 2);
                    o = mfma16(sa, qb, o);
                }
                oacc[i] = o;
            }
        }
        {
            bf16x8 ka[2];
#pragma unroll
            for (int kk = 0; kk < 2; ++kk) ka[kk] = *(const LAS bf16x8*)(lds + HKT + (16 * wid + fr) * 144 + (32 * kk + 8 * g) * 2);
            float eg[4];
#pragma unroll
            for (int r = 0; r < 4; ++r) eg[r] = EG[16 * wid + 4 * g + r];
#pragma unroll
            for (int vt = 0; vt < 8; ++vt) {
                f32x4 L = st[vt];
#pragma unroll
                for (int kk = 0; kk < 2; ++kk) { const bf16x8 vb = *(const LAS bf16x8*)(lds + HVT + (16 * vt + fr) * 144 + (32 * kk + 8 * g) * 2); L = mfma16(ka[kk], vb, L); }
#pragma unroll
                for (int r = 0; r < 4; ++r) st[vt][r] = eg[r] * L[r];
            }
        }
        if (FULL) {
            __syncthreads();
            const int ttl = wid & 3, tq = 16 * ttl + fr;
            float ss = 0.f;
#pragma unroll
            for (int i = 0; i < 4; ++i) {
                const int vt = 4 * (wid >> 2) + i; f32x4 o = oacc[i];
#pragma unroll
                for (int kk = 0; kk < 2; ++kk) {
                    const bf16x8 va = *(const LAS bf16x8*)(lds + HVT + (16 * vt + fr) * 144 + (32 * kk + 8 * g) * 2);
                    const bf16x8 pb = *(const LAS bf16x8*)(lds + HP + tq * 144 + (32 * kk + 8 * g) * 2);
                    o = mfma16(va, pb, o);
                }
                oacc[i] = o; ss += o[0] * o[0] + o[1] * o[1] + o[2] * o[2] + o[3] * o[3];
            }
            ss += __shfl_xor(ss, 16); ss += __shfl_xor(ss, 32);
            if (g == 0) RS[(wid >> 2) * 64 + tq] = ss;
            __syncthreads();
            const float rn = rsqrtf((RS[tq] + RS[64 + tq]) * (1.0f / 128.0f) + 1e-6f);
            const float* nw = a.in[3] + col0;
#pragma unroll
            for (int i = 0; i < 4; ++i) {
                const int v0 = 16 * (4 * (wid >> 2) + i) + 4 * g;
                const size_t off = (size_t)(t0 + tq) * 1024 + col0 + v0;
                const u32x2 sg = *(const u32x2*)(SG + off); const f32x4 w4 = *(const f32x4*)(nw + v0);
                u32x2 w; w.x = cvt_pk_bf16(oacc[i][0] * rn * w4[0] * bflo(sg.x), oacc[i][1] * rn * w4[1] * bfhi(sg.x));
                w.y = cvt_pk_bf16(oacc[i][2] * rn * w4[2] * bflo(sg.y), oacc[i][3] * rn * w4[3] * bfhi(sg.y));
                *(u32x2*)(YA + off) = w;
            }
        }
    }
    if (!FULL) {
        float* sp = SEG + (size_t)item * 16384;
#pragma unroll
        for (int vt = 0; vt < 8; ++vt)
#pragma unroll
            for (int r = 0; r < 4; ++r) sp[(16 * wid + 4 * g + r) * 128 + 16 * vt + fr] = st[vt][r];
        if (tg == 0) GT[item * 128 + d] = gsum;
    }
    __syncthreads();
}

constexpr int MKM = 0, MSEL = 8192, MKB = 9216, MVB = MKB + 2 * 17408, KST = 272, VST = 288;
template <int OFF> __device__ __forceinline__ s16x4 tr_read(unsigned vb) { s16x4 r; asm volatile("ds_read_b64_tr_b16 %0, %1 offset:%2" : "=&v"(r) : "v"(vb), "i"(OFF) : "memory"); return r; }
template <int C, int VT0> __device__ __forceinline__ void pv_quad(f32x4 (&O)[2][8], unsigned vb, const bf16x8 (&pf)[2][2]) {
    const s16x4 a0 = tr_read<(32 * C) * VST + 32 * (VT0 + 0)>(vb), b0 = tr_read<(32 * C + 16) * VST + 32 * (VT0 + 0)>(vb);
    const s16x4 a1 = tr_read<(32 * C) * VST + 32 * (VT0 + 1)>(vb), b1 = tr_read<(32 * C + 16) * VST + 32 * (VT0 + 1)>(vb);
    const s16x4 a2 = tr_read<(32 * C) * VST + 32 * (VT0 + 2)>(vb), b2 = tr_read<(32 * C + 16) * VST + 32 * (VT0 + 2)>(vb);
    const s16x4 a3 = tr_read<(32 * C) * VST + 32 * (VT0 + 3)>(vb), b3 = tr_read<(32 * C + 16) * VST + 32 * (VT0 + 3)>(vb);
    asm volatile("s_waitcnt lgkmcnt(0)" ::: "memory");
    __builtin_amdgcn_sched_barrier(0);
    const bf16x8 v0 = {a0[0], a0[1], a0[2], a0[3], b0[0], b0[1], b0[2], b0[3]}, v1 = {a1[0], a1[1], a1[2], a1[3], b1[0], b1[1], b1[2], b1[3]};
    const bf16x8 v2 = {a2[0], a2[1], a2[2], a2[3], b2[0], b2[1], b2[2], b2[3]}, v3 = {a3[0], a3[1], a3[2], a3[3], b3[0], b3[1], b3[2], b3[3]};
#pragma unroll
    for (int qs = 0; qs < 2; ++qs) {
        O[qs][VT0 + 0] = mfma16(v0, pf[qs][C], O[qs][VT0 + 0]); O[qs][VT0 + 1] = mfma16(v1, pf[qs][C], O[qs][VT0 + 1]);
        O[qs][VT0 + 2] = mfma16(v2, pf[qs][C], O[qs][VT0 + 2]); O[qs][VT0 + 3] = mfma16(v3, pf[qs][C], O[qs][VT0 + 3]);
    }
}
__device__ __forceinline__ void moba_item(LAS unsigned char* lds, const Args& a, int b, int h, int j) {
    unsigned char* ws = a.ws;
    int tid_ = threadIdx.x; asm volatile("" : "+v"(tid_));
    const int tid = tid_, wid = tid >> 6, lane = tid & 63, fr = lane & 15, g = lane >> 4;
    const bf16_t* MQ = (const bf16_t*)(ws + O_MQ); const bf16_t* MK = (const bf16_t*)(ws + O_MK); const bf16_t* MV = (const bf16_t*)(ws + O_MV);
    bf16_t* YB = (bf16_t*)(ws + O_YB); const float* KMg = (const float*)(ws + O_KM) + (size_t)(b * 8 + h) * 2048;
    const int tokb = b * S_, qrow0 = tokb + 256 * j, col0 = h * 128;
    LAS float* KM = (LAS float*)(lds + MKM); LAS unsigned* SEL = (LAS unsigned*)(lds + MSEL);
    *(LAS f32x4*)(lds + MKM + tid * 16) = *(const f32x4*)(KMg + tid * 4);
    __syncthreads();
    {
        const int q = tid >> 1, half = tid & 1;
        const bf16_t* qp = MQ + (size_t)(qrow0 + q) * 1024 + col0 + 64 * half;
        u32x4 qw[8];
#pragma unroll
        for (int i = 0; i < 8; ++i) qw[i] = *(const u32x4*)(qp + 8 * i);
        float b0 = -INFINITY, b1 = -INFINITY, b2 = -INFINITY; int i0 = -1, i1 = -1, i2 = -1;
        for (int n = 0; n < j; ++n) {
            const LAS float* kp = KM + n * 128 + 64 * half; float s = 0.f;
#pragma unroll
            for (int i = 0; i < 8; ++i) { const f32x4 ka = *(const LAS f32x4*)(kp + 8 * i), kb = *(const LAS f32x4*)(kp + 8 * i + 4);
                s += bflo(qw[i].x) * ka[0] + bfhi(qw[i].x) * ka[1] + bflo(qw[i].y) * ka[2] + bfhi(qw[i].y) * ka[3] + bflo(qw[i].z) * kb[0] + bfhi(qw[i].z) * kb[1] + bflo(qw[i].w) * kb[2] + bfhi(qw[i].w) * kb[3]; }
            s += __shfl_xor(s, 1);
            if (s > b0) { b2 = b1; i2 = i1; b1 = b0; i1 = i0; b0 = s; i0 = n; }
            else if (s > b1) { b2 = b1; i2 = i1; b1 = s; i1 = n; }
            else if (s > b2) { b2 = s; i2 = n; }
        }
        unsigned m = 0; if (i0 >= 0) m |= 1u << i0; if (i1 >= 0) m |= 1u << i1; if (i2 >= 0) m |= 1u << i2;
        if (half == 0) SEL[q] = m;
    }
    __syncthreads();
    bf16x8 qf[2][4]; unsigned selm[2]; f32x4 O[2][8]; float mrow[2], lrow[2];
#pragma unroll
    for (int qs = 0; qs < 2; ++qs) {
        const int t = 32 * wid + 16 * qs + fr;
#pragma unroll
        for (int kk = 0; kk < 4; ++kk) qf[qs][kk] = *(const bf16x8*)(MQ + (size_t)(qrow0 + t) * 1024 + col0 + 32 * kk + 8 * g);
        selm[qs] = SEL[t]; mrow[qs] = -INFINITY; lrow[qs] = 0.f;
#pragma unroll
        for (int vt = 0; vt < 8; ++vt) O[qs][vt] = (f32x4){0.f, 0.f, 0.f, 0.f};
    }
    const int ntile = 4 * (j + 1);
    const int lr = tid >> 3, lc = tid & 7;
    u32x4 kreg0, kreg1, vreg0, vreg1;
#define gload(it_) do { const size_t rb = (size_t)(tokb + 64 * (it_) + lr) * 1024 + col0 + 8 * lc; \
        kreg0 = *(const u32x4*)(MK + rb); kreg1 = *(const u32x4*)(MK + rb + 64); vreg0 = *(const u32x4*)(MV + rb); vreg1 = *(const u32x4*)(MV + rb + 64); } while (0)
#define lstore(buf_) do { *(LAS u32x4*)(lds + MKB + (buf_) * 17408 + lr * KST + 16 * lc) = kreg0; *(LAS u32x4*)(lds + MKB + (buf_) * 17408 + lr * KST + 16 * lc + 128) = kreg1; \
        *(LAS u32x4*)(lds + MVB + (buf_) * 18432 + lr * VST + 16 * lc) = vreg0; *(LAS u32x4*)(lds + MVB + (buf_) * 18432 + lr * VST + 16 * lc + 128) = vreg1; } while (0)
    gload(0); lstore(0);
    __syncthreads();
    for (int it = 0; it < ntile; ++it) {
        const int buf = it & 1, n = it >> 2, kt = it & 3;
        if (it + 1 < ntile) gload(it + 1);
        const bool own = (n == j);
        const bool sel0 = own || ((selm[0] >> n) & 1u), sel1 = own || ((selm[1] >> n) & 1u);
        const bool active = own ? (kt <= (wid >> 1)) : (__ballot(sel0 || sel1) != 0ull);
        if (active) {
            f32x4 s[2][4];
            const unsigned kb = MKB + buf * 17408;
#pragma unroll
            for (int at = 0; at < 4; ++at) {
                bf16x8 kf[4];
#pragma unroll
                for (int kk = 0; kk < 4; ++kk) kf[kk] = *(const LAS bf16x8*)(lds + kb + (16 * at + fr) * KST + (32 * kk + 8 * g) * 2);
#pragma unroll
                for (int qs = 0; qs < 2; ++qs) { f32x4 c = {0.f, 0.f, 0.f, 0.f};
#pragma unroll
                    for (int kk = 0; kk < 4; ++kk) c = mfma16(kf[kk], qf[qs][kk], c);
                    s[qs][at] = c; }
            }
            bf16x8 pf[2][2];
#pragma unroll
            for (int qs = 0; qs < 2; ++qs) {
                const bool sl = qs == 0 ? sel0 : sel1;
                const int qpos = 32 * wid + 16 * qs + fr;
                float mx = -INFINITY;
#pragma unroll
                for (int at = 0; at < 4; ++at)
#pragma unroll
                    for (int r = 0; r < 4; ++r) {
                        const int kpos = 64 * kt + 16 * at + 4 * g + r;
                        const bool ok = own ? (kpos <= qpos) : sl;
                        const float v = ok ? s[qs][at][r] : -INFINITY;
                        s[qs][at][r] = v; mx = fmaxf(mx, v);
                    }
                mx = fmaxf(mx, __shfl_xor(mx, 16)); mx = fmaxf(mx, __shfl_xor(mx, 32));
                const float mnew = fmaxf(mrow[qs], mx);
                const float msafe = mnew == -INFINITY ? 0.f : mnew;
                const float alpha = exp2f(mrow[qs] - msafe);
                mrow[qs] = mnew;
                float ps = 0.f; float p[4][4];
#pragma unroll
                for (int at = 0; at < 4; ++at)
#pragma unroll
                    for (int r = 0; r < 4; ++r) { p[at][r] = exp2f(s[qs][at][r] - msafe); ps += p[at][r]; }
                lrow[qs] = lrow[qs] * alpha + ps;
#pragma unroll
                for (int vt = 0; vt < 8; ++vt) O[qs][vt] *= alpha;
#pragma unroll
                for (int c = 0; c < 2; ++c) {
                    const unsigned w0 = cvt_pk_bf16(p[2 * c][0], p[2 * c][1]), w1 = cvt_pk_bf16(p[2 * c][2], p[2 * c][3]), w2 = cvt_pk_bf16(p[2 * c + 1][0], p[2 * c + 1][1]), w3 = cvt_pk_bf16(p[2 * c + 1][2], p[2 * c + 1][3]);
                    const u32x4 w = {w0, w1, w2, w3}; pf[qs][c] = __builtin_bit_cast(bf16x8, w);
                }
            }
            const unsigned vb = (unsigned)(MVB + buf * 18432 + (4 * g + (fr >> 2)) * VST + 8 * (fr & 3));
            pv_quad<0, 0>(O, vb, pf); pv_quad<0, 4>(O, vb, pf); pv_quad<1, 0>(O, vb, pf); pv_quad<1, 4>(O, vb, pf);
        }
        if (it + 1 < ntile) lstore(buf ^ 1);
        __syncthreads();
    }
#pragma unroll
    for (int qs = 0; qs < 2; ++qs) {
        float l = lrow[qs]; l += __shfl_xor(l, 16); l += __shfl_xor(l, 32);
        const float inv = 1.0f / l;
        const int t = 32 * wid + 16 * qs + fr;
        bf16_t* yp = YB + (size_t)(qrow0 + t) * 1024 + col0 + 4 * g;
#pragma unroll
        for (int vt = 0; vt < 8; ++vt) { u32x2 w; w.x = cvt_pk_bf16(O[qs][vt][0] * inv, O[qs][vt][1] * inv); w.y = cvt_pk_bf16(O[qs][vt][2] * inv, O[qs][vt][3] * inv); *(u32x2*)(yp + 16 * vt) = w; }
    }
    __syncthreads();
}

__device__ __forceinline__ void ln_phase(const float* src, const float* w, const float* bsh, float* dstf, bf16_t* dstb) {
    int tid_ = threadIdx.x; asm volatile("" : "+v"(tid_));
    const int tid = tid_, wid = tid >> 6, lane = tid & 63;
    for (int row = blockIdx.x * 8 + wid; row < T_; row += gridDim.x * 8) {
        const float* p = src + (size_t)row * 1024;
        f32x4 v[4]; float s = 0.f;
#pragma unroll
        for (int i = 0; i < 4; ++i) { v[i] = *(const f32x4*)(p + 256 * i + 4 * lane); s += v[i][0] + v[i][1] + v[i][2] + v[i][3]; }
#pragma unroll
        for (int sh = 1; sh < 64; sh <<= 1) s += __shfl_xor(s, sh);
        const float mu = s * (1.0f / 1024.0f); float q = 0.f;
#pragma unroll
        for (int i = 0; i < 4; ++i) { v[i] -= mu; q += v[i][0] * v[i][0] + v[i][1] * v[i][1] + v[i][2] * v[i][2] + v[i][3] * v[i][3]; }
#pragma unroll
        for (int sh = 1; sh < 64; sh <<= 1) q += __shfl_xor(q, sh);
        const float rs = rsqrtf(q * (1.0f / 1024.0f) + 1e-5f);
#pragma unroll
        for (int i = 0; i < 4; ++i) {
            const int c = 256 * i + 4 * lane;
            const f32x4 y = v[i] * rs * *(const f32x4*)(w + c) + *(const f32x4*)(bsh + c);
            *(f32x4*)(dstf + (size_t)row * 1024 + c) = y;
            if (dstb) { u32x2 o; o.x = cvt_pk_bf16(y[0], y[1]); o.y = cvt_pk_bf16(y[2], y[3]); *(u32x2*)(dstb + (size_t)row * 1024 + c) = o; }
        }
    }
}


#define XB_TMO      128
#define XB_XCNT(j)  (256  + 64 * (j))
#define XB_XSUB(j)  (1280 + 64 * (j))
#define XB_XGEN(j)  (2304 + 64 * (j))
#define XB_TOP      3328
#define XB_TOPGEN   3392
#define XCD_BAR_WORDS 3456
#define XB_SPIN_CAP (1u << 18)
__device__ __forceinline__ unsigned xb_ld(unsigned* p)              { return __hip_atomic_load(p, __ATOMIC_RELAXED, __HIP_MEMORY_SCOPE_AGENT); }
__device__ __forceinline__ unsigned xb_add(unsigned* p, unsigned v) { return __hip_atomic_fetch_add(p, v, __ATOMIC_RELAXED, __HIP_MEMORY_SCOPE_AGENT); }
__device__ __forceinline__ unsigned xb_xcc_id() { return (unsigned)__builtin_amdgcn_s_getreg((3 << 11) | 20) & 0xFu; }
#define XB_SPIN(cond, bar) do { unsigned _sp = 0; while (cond) { __builtin_amdgcn_s_sleep(1); \
    if ((++_sp & 255u) == 0u) { if (xb_ld(&(bar)[XB_TMO])) break; if (_sp > XB_SPIN_CAP) { atomicAdd(&(bar)[XB_TMO], 1u); break; } } } } while (0)
struct XcdBarrier { unsigned* bar; unsigned x; volatile LAS unsigned* st; };
__device__ __forceinline__ XcdBarrier xcd_barrier_post(unsigned* bar, volatile LAS unsigned* st) {
    XcdBarrier b; b.bar = bar; b.x = xb_xcc_id(); b.st = st;
    if (threadIdx.x == 0) (void)xb_add(&bar[XB_XCNT(b.x)], 1u);
    return b;
}
__device__ __forceinline__ void xcd_barrier_complete(unsigned* bar, unsigned x, unsigned& nloc, unsigned& nx) {
    const unsigned G = gridDim.x * gridDim.y * gridDim.z;
    unsigned sum, cnt, mine, sp = 0u;
    for (;;) {
        sum = 0u; cnt = 0u; mine = 0u;
#pragma unroll
        for (unsigned j = 0; j < 16; ++j) { const unsigned c = xb_ld(&bar[XB_XCNT(j)]); sum += c; cnt += (c > 0u) ? 1u : 0u; mine = (j == x) ? c : mine; }
        if (sum == G) break;
        __builtin_amdgcn_s_sleep(1);
        if ((++sp & 255u) == 0u) { if (xb_ld(&bar[XB_TMO])) break; if (sp > XB_SPIN_CAP) { atomicAdd(&bar[XB_TMO], 1u); break; } }
    }
    nloc = mine > 0u ? mine : 1u; nx = cnt > 0u ? cnt : 1u;
}
__device__ __forceinline__ void xcd_barrier(const XcdBarrier& b) {
    asm volatile("s_waitcnt vmcnt(0)" ::: "memory");
    __syncthreads();
    if (threadIdx.x == 0) {
        unsigned* bar = b.bar;
        __builtin_amdgcn_s_waitcnt(0);
        unsigned nloc = b.st[0], nx = b.st[1];
        if (nloc == 0u) { xcd_barrier_complete(bar, b.x, nloc, nx); b.st[0] = nloc; b.st[1] = nx; }
        const unsigned old = xb_add(&bar[XB_XSUB(b.x)], 1u);
        const unsigned gen = old / nloc;
        if (old + 1u == (gen + 1u) * nloc) {
            __builtin_amdgcn_fence(__ATOMIC_RELEASE, "agent");
            asm volatile("s_waitcnt vmcnt(0)" ::: "memory");
            const unsigned og = xb_add(&bar[XB_TOP], 1u);
            const unsigned tg = og / nx;
            if (og + 1u == (tg + 1u) * nx) xb_add(&bar[XB_TOPGEN], 1u);
            else XB_SPIN(xb_ld(&bar[XB_TOPGEN]) == tg, bar);
            __builtin_amdgcn_fence(__ATOMIC_ACQUIRE, "agent");
            xb_add(&bar[XB_XGEN(b.x)], 1u);
            asm volatile("s_waitcnt vmcnt(0)" ::: "memory");
        } else {
            XB_SPIN(xb_ld(&bar[XB_XGEN(b.x)]) == gen, bar);
            __builtin_amdgcn_fence(__ATOMIC_ACQUIRE, "agent");
            asm volatile("s_waitcnt vmcnt(0)" ::: "memory");
        }
    }
    __syncthreads();
}

__global__ void __launch_bounds__(512, 2) hybrid_fwd(Args a) {
    extern __shared__ __attribute__((aligned(16))) unsigned char lds_raw[];
    LAS unsigned char* lds = (LAS unsigned char*)lds_raw;
    unsigned char* ws = a.ws;
    pg8::StaticOrder S;
    if (threadIdx.x == 0) { *(LAS unsigned*)(lds + 131072) = 0u; *(LAS unsigned*)(lds + 131076) = 0u; }
    __syncthreads();
    const XcdBarrier xbar = xcd_barrier_post((unsigned*)(ws + O_BAR), (volatile LAS unsigned*)(lds + 131072));
    for (int ph = a.ph_lo; ph < a.ph_hi; ++ph) {
      for (int rep = 0; rep < (((REPEAT_MASK >> ph) & 1) ? 2 : 1); ++rep) {
        switch (ph) {
        case 0: prep_phase(lds, a); break;
        case 1: { pg8::Gemm g{(const bf16_t*)(ws + O_XB), (const bf16_t*)(ws + O_XB), (const bf16_t*)(ws + O_WIN), T_, 6144, 1024, 1024, 1 << 20};
            EpiProjA E{(bf16_t*)(ws + O_QF), (_Float16*)(ws + O_LF), (bf16_t*)(ws + O_VH), (bf16_t*)(ws + O_SG), (bf16_t*)a.out, (bf16_t*)a.out + (size_t)T_ * 1024, (const float*)(ws + O_LB), a.in[6]};
            S.init(T_, 6144, gridDim.x, blockIdx.x); pg8::gemm_phase(lds, g, S, E); } break;
        case 2: for (int it = blockIdx.x; it < 256; it += gridDim.x) if ((it & 7) != 7) hgrn_item<false>(lds, a, it); break;
        case 3: for (int it = blockIdx.x; it < 256; it += gridDim.x) hgrn_item<true>(lds, a, it); break;
        case 4: { pg8::Gemm g{(const bf16_t*)(ws + O_XB), (const bf16_t*)(ws + O_XB), (const bf16_t*)(ws + O_WIN) + (size_t)6144 * 1024, T_, 3072, 1024, 1024, 1 << 20};
            EpiProjB E{(bf16_t*)(ws + O_MQ), (bf16_t*)(ws + O_MK), (bf16_t*)(ws + O_MV), (float*)(ws + O_KM), (const float*)(ws + O_COS), (const float*)(ws + O_SIN)};
            S.init(T_, 3072, gridDim.x, blockIdx.x); pg8::gemm_phase(lds, g, S, E); } break;
        case 5: for (int pr = blockIdx.x; pr < 256; pr += gridDim.x) { const int bh = pr >> 3, jj = pr & 7; for (int k2 = 0; k2 < 2; ++k2) moba_item(lds, a, bh >> 3, bh & 7, k2 ? jj : 15 - jj); } break;
        case 6: { pg8::Gemm g{(const bf16_t*)(ws + O_YB), (const bf16_t*)(ws + O_YA), (const bf16_t*)(ws + O_WBR), T_, 1024, 2048, 1024, 16};
            EpiBranch E{(const bf16_t*)a.out, (const bf16_t*)a.out + (size_t)T_ * 1024, (bf16_t*)(ws + O_MM)};
            S.init(T_, 1024, gridDim.x, blockIdx.x); pg8::gemm_phase(lds, g, S, E); } break;
        case 7: { pg8::Gemm g{(const bf16_t*)(ws + O_MM), (const bf16_t*)(ws + O_MM), (const bf16_t*)(ws + O_WOUT), T_, 1024, 1024, 1024, 1 << 20};
            EpiRes E{a.in[0], (float*)(ws + O_R1)};
            S.init(T_, 1024, gridDim.x, blockIdx.x); pg8::gemm_phase(lds, g, S, E); } break;
        case 8: ln_phase((const float*)(ws + O_R1), a.in[8], a.in[9], a.out, (bf16_t*)(ws + O_X1B)); break;
        case 9: { pg8::Gemm g{(const bf16_t*)(ws + O_X1B), (const bf16_t*)(ws + O_X1B), (const bf16_t*)(ws + O_WFI), T_, 2 * DFF, 1024, 1024, 1 << 20};
            EpiFfnIn E{(bf16_t*)(ws + O_ACT)};
            S.init(T_, 2 * DFF, gridDim.x, blockIdx.x); pg8::gemm_phase(lds, g, S, E); } break;
        case 10: { pg8::Gemm g{(const bf16_t*)(ws + O_ACT), (const bf16_t*)(ws + O_ACT), (const bf16_t*)(ws + O_WFD), T_, 1024, DFF, DFF, 1 << 20};
            EpiRes E{a.out, (float*)(ws + O_R2)};
            S.init(T_, 1024, gridDim.x, blockIdx.x); pg8::gemm_phase(lds, g, S, E); } break;
        case 11: ln_phase((const float*)(ws + O_R2), a.in[12], a.in[13], a.out, nullptr); break;
        }
      }
        if (ph + 1 < a.ph_hi) { if (ph == 0) cg::this_grid().sync(); else xcd_barrier(xbar); }
    }
}

extern "C" void kernel_launch(void* const* d_in, const int* in_sizes, int n_in, void* d_out, int out_size, void* d_ws, size_t ws_size, hipStream_t stream) {
    static int grid = 0;
    if (grid == 0) {
        int dev = 0, cus = 0, per_cu = 0;
        hipGetDevice(&dev); hipDeviceGetAttribute(&cus, hipDeviceAttributeMultiprocessorCount, dev);
        hipFuncSetAttribute((const void*)hybrid_fwd, hipFuncAttributeMaxDynamicSharedMemorySize, LDS_BYTES);
        hipOccupancyMaxActiveBlocksPerMultiprocessor(&per_cu, (const void*)hybrid_fwd, 512, LDS_BYTES);
        if (per_cu < 1) { fprintf(stderr, "kernel_launch: occupancy query reports %d blocks per CU\n", per_cu); per_cu = 1; }
        if (per_cu > 1) per_cu = 1;
        grid = cus * per_cu;
        if (ws_size < 252 * MB) fprintf(stderr, "kernel_launch: workspace too small: %zu\n", ws_size);
    }
    (void)hipMemsetAsync((unsigned char*)d_ws + O_BAR, 0, XCD_BAR_WORDS * 4, stream);
    Args a{};
    for (int i = 0; i < 14; ++i) a.in[i] = (const float*)d_in[i];
    a.out = (float*)d_out; a.ws = (unsigned char*)d_ws;
#if N_LAUNCH_MODE == 1
    a.ph_lo = 0; a.ph_hi = NPHASE;
    void* args[] = {&a};
    hipError_t e = hipLaunchCooperativeKernel((const void*)hybrid_fwd, dim3(grid), dim3(512), args, LDS_BYTES, stream);
    if (e != hipSuccess) fprintf(stderr, "cooperative launch failed: %s (grid %d)\n", hipGetErrorString(e), grid);
#else
    for (int ph = 0; ph < NPHASE; ++ph) { a.ph_lo = ph; a.ph_hi = ph + 1; hipLaunchKernelGGL(hybrid_fwd, dim3(grid), dim3(512), LDS_BYTES, stream, a); }
#endif
}
```

```cpp
#include <hip/hip_runtime.h>
#include <hip/hip_cooperative_groups.h>
#include <cstdio>
namespace cg = cooperative_groups;

#define LAS __attribute__((address_space(3)))
typedef unsigned short bf16_t;
typedef short bf16x8 __attribute__((ext_vector_type(8)));
typedef short s16x4 __attribute__((ext_vector_type(4)));
typedef float f32x4 __attribute__((ext_vector_type(4)));
typedef unsigned u32x4 __attribute__((ext_vector_type(4)));
typedef unsigned u32x2 __attribute__((ext_vector_type(2)));
typedef _Float16 h16x8 __attribute__((ext_vector_type(8)));

#ifndef N_LAUNCH_MODE
#define N_LAUNCH_MODE 1
#endif

constexpr int T_ = 16384, D_ = 1024, S_ = 4096, DFF = 2816;
constexpr float DN_ALPHA = 1.189207115002721f;
constexpr size_t MB = 1u << 20;
constexpr size_t O_XB = 0, O_MM = 0, O_WIN = 32 * MB, O_WBR = 50 * MB, O_WOUT = 54 * MB, O_WFI = 56 * MB, O_WFD = 67 * MB,
                 O_COS = 73 * MB, O_SIN = 74 * MB, O_KM = 75 * MB, O_LB = 75 * MB + 256 * 1024, O_GT = 75 * MB + 512 * 1024, O_SEG = 76 * MB,
                 O_QF = 92 * MB, O_LF = 124 * MB, O_VH = 156 * MB, O_SG = 188 * MB, O_YA = 220 * MB,
                 O_MQ = 92 * MB, O_MK = 124 * MB, O_MV = 156 * MB, O_YB = 188 * MB, O_R1 = 92 * MB, O_X1B = 220 * MB, O_ACT = 76 * MB, O_R2 = 164 * MB;
constexpr int LDS_BYTES = 131072 + 16;
constexpr size_t O_BAR = 75 * MB + 768 * 1024;
constexpr int NPHASE = 12;
#ifndef REPEAT_MASK
#define REPEAT_MASK 0
#endif

struct Args { const float* in[14]; float* out; unsigned char* ws; int ph_lo, ph_hi; };

__device__ __forceinline__ unsigned cvt_pk_bf16(float lo, float hi) { unsigned r; asm("v_cvt_pk_bf16_f32 %0, %1, %2" : "=v"(r) : "v"(lo), "v"(hi)); return r; }
__device__ __forceinline__ float bf2f(unsigned short b) { return __uint_as_float(((unsigned)b) << 16); }
__device__ __forceinline__ float bflo(unsigned w) { return __uint_as_float(w << 16); }
__device__ __forceinline__ float bfhi(unsigned w) { return __uint_as_float(w & 0xffff0000u); }
__device__ __forceinline__ float sigmoidf_(float x) { return __builtin_amdgcn_rcpf(1.0f + __expf(-x)); }
__device__ __forceinline__ float siluf_(float x) { return x * sigmoidf_(x); }
__device__ __forceinline__ u32x4 pack8(const f32x4& a, const f32x4& b) { u32x4 w; w.x = cvt_pk_bf16(a[0], a[1]); w.y = cvt_pk_bf16(a[2], a[3]); w.z = cvt_pk_bf16(b[0], b[1]); w.w = cvt_pk_bf16(b[2], b[3]); return w; }

namespace pg8 {
constexpr int BM = 256, BK = 64, HALF = 128, HTB = HALF * BK * 2, STAGE_BYTES = 8 * HTB, NXCD = 8, WGM = 8;
__device__ __forceinline__ int lds_byte(int r, int c) { const int st = (r >> 4) * 2 + (c >> 5), rr = r & 15, cc = c & 31, ob = rr * 64 + cc * 2; return st * 1024 + (ob ^ (((ob >> 9) & 1) << 5)); }
__device__ __forceinline__ void stage_rc(int b, int& R, int& C) { const int st = b / 1024, sb = b % 1024, swz = sb ^ (((sb >> 9) & 1) << 5); R = (st >> 1) * 16 + swz / 64; C = (st & 1) * 32 + (swz % 64) / 2; }
__device__ __forceinline__ int perm32(int rho) { const int n = rho >> 4, i = rho & 15; return 8 * (i >> 2) + 4 * n + (i & 3); }
struct Unit { int pm, pn; };
struct Gemm { const bf16_t* A; const bf16_t* A2; const bf16_t* Bt; int M, N, K, lda, ksplit; };
struct StaticOrder {
    int nM, nN, nwg, G, c;
    __device__ void init(int M, int N, int G_, int c_) { nM = M / BM; nN = N / BM; nwg = nM * nN; G = G_; c = c_; }
    __device__ bool next(int i, Unit& u) const {
        const long L = (long)i * G + c; if (L >= nwg) return false;
        int wgid = (int)L; { const int q = nwg / NXCD, r = nwg % NXCD, xcd = wgid % NXCD, off = wgid / NXCD; wgid = (xcd < r ? xcd * (q + 1) : r * (q + 1) + (xcd - r) * q) + off; }
        const int nig = WGM * nN, gid = wgid / nig, fm = gid * WGM, gsz = (nM - fm) < WGM ? (nM - fm) : WGM;
        u.pm = fm + ((wgid % nig) % gsz); u.pn = (wgid % nig) / gsz; return true;
    }
};
template <class Epi>
__device__ __forceinline__ void gemm_phase(LAS unsigned char* lds, const Gemm g, const StaticOrder& S, const Epi& E) {
    int tid_ = threadIdx.x; asm volatile("" : "+v"(tid_));
    const int tid = tid_, wid = __builtin_amdgcn_readfirstlane(tid >> 6), lane = tid & 63, wr = wid >> 2, wc = wid & 3, fr = lane & 15, fq = lane >> 4;
    const int K = g.K, nt = K / BK, ks = g.ksplit;
    unsigned voffA[2], voffB[2];
#pragma unroll
    for (int i = 0; i < 2; ++i) { int R, C; stage_rc(tid * 16 + i * 8192, R, C); const int Rb = (R & ~31) + perm32(R & 31);
        voffA[i] = (unsigned)(R * g.lda + C) * 2u; voffB[i] = (unsigned)(Rb * K + C) * 2u; }
    const size_t kstep = (size_t)(BK * 2);
    const size_t hstepA = (size_t)HALF * g.lda * 2, hstepB = (size_t)HALF * K * 2;
    const size_t tstepA = 2 * hstepA, tstepB = 2 * hstepB;
    const unsigned ldsw = (unsigned)wid * 1024u;
    const int aoff = lds_byte(wr * 64 + fr, fq * 8), boff = lds_byte(wc * 32 + fr, fq * 8);
#define PG8_SA(b, h) (((b) * 2 + (h)) * HTB)
#define PG8_SB(b, h) ((4 + (b) * 2 + (h)) * HTB)
#define PG8_STAGE(bufoff, gbase, voff) do { _Pragma("unroll") for (int _i = 0; _i < 2; ++_i) \
        __builtin_amdgcn_global_load_lds((const unsigned*)((const char*)(gbase) + (voff)[_i]), (LAS unsigned*)(lds + (bufoff) + ldsw + _i * 8192), 16, 0, 0); } while (0)
#define PG8_LDA(dst, b, h) do { _Pragma("unroll") for (int m = 0; m < 4; ++m) _Pragma("unroll") for (int k = 0; k < 2; ++k) dst[m][k] = *(const LAS bf16x8*)(lds + PG8_SA(b, h) + aoff + m * 2048 + k * 1024); } while (0)
#define PG8_LDB(dst, b, h) do { _Pragma("unroll") for (int n = 0; n < 2; ++n) _Pragma("unroll") for (int k = 0; k < 2; ++k) dst[n][k] = *(const LAS bf16x8*)(lds + PG8_SB(b, h) + boff + n * 2048 + k * 1024); } while (0)
#define PG8_MMA(ai, bj, At, Bt) do { __builtin_amdgcn_s_setprio(1); _Pragma("unroll") for (int m = 0; m < 4; ++m) _Pragma("unroll") for (int n = 0; n < 2; ++n) _Pragma("unroll") for (int k = 0; k < 2; ++k) \
        acc[ai][bj][m][n] = __builtin_amdgcn_mfma_f32_16x16x32_bf16(Bt[n][k], At[m][k], acc[ai][bj][m][n], 0, 0, 0); __builtin_amdgcn_s_setprio(0); } while (0)
#define PG8_WAIT_V(n) asm volatile("s_waitcnt vmcnt(" #n ")" ::: "memory")
#define PG8_WAIT_L(n) asm volatile("s_waitcnt lgkmcnt(" #n ")" ::: "memory")
#define PG8_BAR __builtin_amdgcn_s_barrier()
#define PG8_SCHED __builtin_amdgcn_sched_barrier(0)
    Unit cur, nxt; int ui = 0;
    if (!S.next(0, cur)) return;
    f32x4 acc[2][2][4][2];
#pragma unroll
    for (int a = 0; a < 2; ++a)
#pragma unroll
        for (int b = 0; b < 2; ++b)
#pragma unroll
            for (int m = 0; m < 4; ++m)
#pragma unroll
                for (int n = 0; n < 2; ++n) acc[a][b][m][n] = (f32x4){0.f, 0.f, 0.f, 0.f};
    bf16x8 At[4][2], B0[2][2], B1[2][2];
    const char* cA = (const char*)g.A + (size_t)cur.pm * tstepA; const char* cA2 = (const char*)g.A2 + (size_t)cur.pm * tstepA - (size_t)ks * kstep;
    const char* cB = (const char*)g.Bt + (size_t)cur.pn * tstepB;
    PG8_STAGE(PG8_SB(0, 0), cB, voffB); PG8_STAGE(PG8_SA(0, 0), cA, voffA); PG8_STAGE(PG8_SB(0, 1), cB + hstepB, voffB); PG8_STAGE(PG8_SA(0, 1), cA + hstepA, voffA);
    if (wr == 1) PG8_BAR;
    PG8_WAIT_V(4); PG8_BAR;
    PG8_STAGE(PG8_SB(1, 0), cB + kstep, voffB); PG8_STAGE(PG8_SA(1, 0), cA + kstep, voffA); PG8_STAGE(PG8_SB(1, 1), cB + hstepB + kstep, voffB);
    PG8_WAIT_V(6); PG8_BAR;
    for (;;) {
        const bool has_next = S.next(ui + 1, nxt);
        const char* nA = has_next ? (const char*)g.A + (size_t)nxt.pm * tstepA : cA; const char* nB = has_next ? (const char*)g.Bt + (size_t)nxt.pn * tstepB : cB;
        for (int t = 0; t < nt; t += 2) {
            const bool last = (t == nt - 2);
            if constexpr (Epi::HAS_MID) { if (t == ks) E.mid(acc, cur, wr, wc, fr, fq); }
            const char* a1 = ((t + 1) < ks ? cA : cA2) + (size_t)(t + 1) * kstep;
            const char* a2 = last ? nA : ((t + 2) < ks ? cA : cA2) + (size_t)(t + 2) * kstep; const char* b2 = last ? nB : cB + (size_t)(t + 2) * kstep;
            const char* a3 = a2 + kstep; const char* b3 = b2 + kstep;
            PG8_LDB(B0, 0, 0); PG8_SCHED; PG8_LDA(At, 0, 0); PG8_STAGE(PG8_SA(1, 1), a1 + hstepA, voffA);
            PG8_WAIT_L(8); PG8_BAR; PG8_WAIT_L(0); PG8_MMA(0, 0, At, B0); PG8_BAR; PG8_SCHED;
            PG8_LDB(B1, 0, 1); PG8_STAGE(PG8_SB(0, 0), b2, voffB);
            PG8_BAR; PG8_WAIT_L(0); PG8_MMA(0, 1, At, B1); PG8_BAR;
            PG8_LDA(At, 0, 1); PG8_STAGE(PG8_SA(0, 0), a2, voffA);
            PG8_BAR; PG8_WAIT_L(0); PG8_MMA(1, 0, At, B0); PG8_BAR; PG8_SCHED;
            PG8_STAGE(PG8_SB(0, 1), b2 + hstepB, voffB);
            PG8_WAIT_V(6); PG8_BAR; PG8_MMA(1, 1, At, B1); PG8_BAR;
            PG8_LDB(B0, 1, 0); PG8_SCHED; PG8_LDA(At, 1, 0); PG8_STAGE(PG8_SA(0, 1), a2 + hstepA, voffA);
            PG8_WAIT_L(8); PG8_BAR; PG8_WAIT_L(0); PG8_MMA(0, 0, At, B0); PG8_BAR; PG8_SCHED;
            PG8_LDB(B1, 1, 1); PG8_STAGE(PG8_SB(1, 0), b3, voffB);
            PG8_BAR; PG8_WAIT_L(0); PG8_MMA(0, 1, At, B1); PG8_BAR;
            PG8_LDA(At, 1, 1); PG8_STAGE(PG8_SA(1, 0), a3, voffA);
            PG8_BAR; PG8_WAIT_L(0); PG8_MMA(1, 0, At, B0); PG8_BAR; PG8_SCHED;
            PG8_STAGE(PG8_SB(1, 1), b3 + hstepB, voffB);
            PG8_WAIT_V(6); PG8_BAR; PG8_MMA(1, 1, At, B1); PG8_BAR;
        }
        E(acc, cur, wr, wc, fr, fq);
        if (!has_next) break;
#pragma unroll
        for (int a = 0; a < 2; ++a)
#pragma unroll
            for (int b = 0; b < 2; ++b)
#pragma unroll
                for (int m = 0; m < 4; ++m)
#pragma unroll
                    for (int n = 0; n < 2; ++n) acc[a][b][m][n] = (f32x4){0.f, 0.f, 0.f, 0.f};
        cur = nxt; cA = nA; cA2 = (const char*)g.A2 + (size_t)cur.pm * tstepA - (size_t)ks * kstep; cB = nB; ++ui;
    }
    PG8_WAIT_V(0);
    if (wr == 0) PG8_BAR;
    PG8_BAR;
#undef PG8_SA
#undef PG8_SB
#undef PG8_STAGE
#undef PG8_LDA
#undef PG8_LDB
#undef PG8_MMA
#undef PG8_WAIT_V
#undef PG8_WAIT_L
#undef PG8_BAR
#undef PG8_SCHED
}
}
using pg8::Unit;
typedef f32x4 Acc[2][2][4][2];

struct EpiProjA {
    static constexpr bool HAS_MID = false;
    bf16_t* QF; _Float16* LF; bf16_t* VH; bf16_t* SG; bf16_t* GA; bf16_t* GR; const float* lb; const float* bg;
    __device__ __forceinline__ void mid(Acc&, const Unit&, int, int, int, int) const {}
    __device__ __forceinline__ void operator()(const Acc& acc, const Unit& u, int wr, int wc, int fr, int fq) const {
        const int row0 = u.pm * 256 + wr * 64 + fr, seg = u.pn >> 2;
        if (seg < 4) {
            const int cs0 = (u.pn & 3) * 256 + wc * 32 + 8 * fq;
#pragma unroll
            for (int bj = 0; bj < 2; ++bj) {
                const int cs = cs0 + bj * 128;
                f32x4 l0 = {0.f, 0.f, 0.f, 0.f}, l1 = l0;
                if (seg == 1) { l0 = *(const f32x4*)(lb + cs); l1 = *(const f32x4*)(lb + cs + 4); }
#pragma unroll
                for (int ai = 0; ai < 2; ++ai)
#pragma unroll
                    for (int m = 0; m < 4; ++m) {
                        const size_t off = (size_t)(row0 + ai * 128 + m * 16) * 1024 + cs;
                        f32x4 v0 = acc[ai][bj][m][0], v1 = acc[ai][bj][m][1];
                        if (seg == 1) {
                            h16x8 hv;
#pragma unroll
                            for (int j = 0; j < 4; ++j) { hv[j] = (_Float16)__logf(l0[j] + (1.0f - l0[j]) * sigmoidf_(v0[j])); hv[4 + j] = (_Float16)__logf(l1[j] + (1.0f - l1[j]) * sigmoidf_(v1[j])); }
                            *(h16x8*)(LF + off) = hv;
                        } else {
                            if (seg == 0 || seg == 3) {
#pragma unroll
                                for (int j = 0; j < 4; ++j) { v0[j] = siluf_(v0[j]); v1[j] = siluf_(v1[j]); } }
                            const u32x4 pk = pack8(v0, v1);
                            if (seg == 0) *(u32x4*)(QF + off) = pk; else if (seg == 2) *(u32x4*)(VH + off) = pk; else *(u32x4*)(SG + off) = pk;
                        }
                        __builtin_amdgcn_sched_barrier(0);
                    }
            }
        } else {
            const int c = (u.pn - 16) * 128 + wc * 32 + 8 * fq;
            const f32x4 ba0 = *(const f32x4*)(bg + c), ba1 = *(const f32x4*)(bg + c + 4), bb0 = *(const f32x4*)(bg + 1024 + c), bb1 = *(const f32x4*)(bg + 1024 + c + 4);
#pragma unroll
            for (int ai = 0; ai < 2; ++ai)
#pragma unroll
                for (int m = 0; m < 4; ++m) {
                    const size_t off = (size_t)(row0 + ai * 128 + m * 16) * 1024 + c;
                    f32x4 a0, a1, r0, r1;
#pragma unroll
                    for (int j = 0; j < 4; ++j) {
                        a0[j] = sigmoidf_(acc[ai][0][m][0][j] + ba0[j]); a1[j] = sigmoidf_(acc[ai][0][m][1][j] + ba1[j]);
                        r0[j] = sigmoidf_(acc[ai][1][m][0][j] + bb0[j]) / a0[j]; r1[j] = sigmoidf_(acc[ai][1][m][1][j] + bb1[j]) / a1[j]; }
                    *(u32x4*)(GA + off) = pack8(a0, a1); *(u32x4*)(GR + off) = pack8(r0, r1); __builtin_amdgcn_sched_barrier(0);
                }
        }
    }
};
struct EpiProjB {
    static constexpr bool HAS_MID = false;
    bf16_t* MQ; bf16_t* MK; bf16_t* MV; float* KM; const float* COS; const float* SIN;
    __device__ __forceinline__ void mid(Acc&, const Unit&, int, int, int, int) const {}
    __device__ __forceinline__ void operator()(const Acc& acc, const Unit& u, int wr, int wc, int fr, int fq) const {
        const int row0 = u.pm * 256 + wr * 64 + fr, seg = u.pn >> 2;
        if (seg == 2) {
            const int cs0 = (u.pn & 3) * 256 + wc * 32 + 8 * fq;
#pragma unroll
            for (int bj = 0; bj < 2; ++bj)
#pragma unroll
                for (int ai = 0; ai < 2; ++ai)
#pragma unroll
                    for (int m = 0; m < 4; ++m)
                        *(u32x4*)(MV + (size_t)(row0 + ai * 128 + m * 16) * 1024 + cs0 + bj * 128) = pack8(acc[ai][bj][m][0], acc[ai][bj][m][1]);
        } else {
            const int head = 2 * (u.pn & 3) + (wc >> 1), i0 = 32 * (wc & 1) + 8 * fq;
            const float sc = 1.0f;
            f32x4 s1a = {0.f, 0.f, 0.f, 0.f}, s1b = s1a, s2a = s1a, s2b = s1a;
#pragma unroll
            for (int ai = 0; ai < 2; ++ai)
#pragma unroll
                for (int m = 0; m < 4; ++m) {
                    const int row = row0 + ai * 128 + m * 16, pos = row & (S_ - 1);
                    const f32x4 c0 = *(const f32x4*)(COS + pos * 64 + i0), c1 = *(const f32x4*)(COS + pos * 64 + i0 + 4);
                    const f32x4 n0 = *(const f32x4*)(SIN + pos * 64 + i0), n1 = *(const f32x4*)(SIN + pos * 64 + i0 + 4);
                    const f32x4 x1a = acc[ai][0][m][0], x1b = acc[ai][0][m][1], x2a = acc[ai][1][m][0], x2b = acc[ai][1][m][1];
                    f32x4 o1a = (x1a * c0 - x2a * n0) * sc, o1b = (x1b * c1 - x2b * n1) * sc, o2a = (x2a * c0 + x1a * n0) * sc, o2b = (x2b * c1 + x1b * n1) * sc;
                    const size_t off = (size_t)row * 1024 + head * 128 + i0;
                    if (seg == 0) { *(u32x4*)(MQ + off) = pack8(o1a, o1b); *(u32x4*)(MQ + off + 64) = pack8(o2a, o2b); }
                    else { *(u32x4*)(MK + off) = pack8(o1a, o1b); *(u32x4*)(MK + off + 64) = pack8(o2a, o2b); }
                    s1a += o1a; s1b += o1b; s2a += o2a; s2b += o2b;
                    asm volatile("" : "+v"(s1a), "+v"(s1b), "+v"(s2a), "+v"(s2b));
                    __builtin_amdgcn_sched_barrier(0);
                }
            if (seg == 1) {
#pragma unroll
                for (int sh = 1; sh < 16; sh <<= 1)
#pragma unroll
                    for (int j = 0; j < 4; ++j) { s1a[j] += __shfl_xor(s1a[j], sh); s1b[j] += __shfl_xor(s1b[j], sh); s2a[j] += __shfl_xor(s2a[j], sh); s2b[j] += __shfl_xor(s2b[j], sh); }
                if (fr == 0) {
                    float* km = KM + ((size_t)((u.pm >> 4) * 8 + head) * 16 + (u.pm & 15)) * 128 + i0;
#pragma unroll
                    for (int j = 0; j < 4; ++j) { atomicAdd(km + j, s1a[j] * (1.0f / 256.0f)); atomicAdd(km + 4 + j, s1b[j] * (1.0f / 256.0f)); atomicAdd(km + 64 + j, s2a[j] * (1.0f / 256.0f)); atomicAdd(km + 68 + j, s2b[j] * (1.0f / 256.0f)); }
                }
            }
        }
    }
};
struct EpiBranch {
    static constexpr bool HAS_MID = true;
    const bf16_t* GA; const bf16_t* GR; bf16_t* MM;
    __device__ __forceinline__ void mid(Acc& acc, const Unit& u, int wr, int wc, int fr, int fq) const {
        int row0 = u.pm * 256 + wr * 64 + fr; const int c0 = u.pn * 256 + wc * 32 + 8 * fq;
        asm volatile("" : "+v"(row0));
#pragma unroll
        for (int ai = 0; ai < 2; ++ai)
#pragma unroll
            for (int m = 0; m < 4; ++m)
#pragma unroll
                for (int bj = 0; bj < 2; ++bj) {
                    const u32x4 w = *(const u32x4*)(GR + (size_t)(row0 + ai * 128 + m * 16) * 1024 + c0 + bj * 128);
                    acc[ai][bj][m][0] *= (f32x4){bflo(w.x), bfhi(w.x), bflo(w.y), bfhi(w.y)}; acc[ai][bj][m][1] *= (f32x4){bflo(w.z), bfhi(w.z), bflo(w.w), bfhi(w.w)}; __builtin_amdgcn_sched_barrier(0);
                }
    }
    __device__ __forceinline__ void operator()(const Acc& acc, const Unit& u, int wr, int wc, int fr, int fq) const {
        const int row0 = u.pm * 256 + wr * 64 + fr, c0 = u.pn * 256 + wc * 32 + 8 * fq;
#pragma unroll
        for (int ai = 0; ai < 2; ++ai)
#pragma unroll
            for (int m = 0; m < 4; ++m)
#pragma unroll
                for (int bj = 0; bj < 2; ++bj) {
                    const size_t off = (size_t)(row0 + ai * 128 + m * 16) * 1024 + c0 + bj * 128;
                    const u32x4 w = *(const u32x4*)(GA + off);
                    *(u32x4*)(MM + off) = pack8(acc[ai][bj][m][0] * (f32x4){bflo(w.x), bfhi(w.x), bflo(w.y), bfhi(w.y)}, acc[ai][bj][m][1] * (f32x4){bflo(w.z), bfhi(w.z), bflo(w.w), bfhi(w.w)}); __builtin_amdgcn_sched_barrier(0);
                }
    }
};
struct EpiRes {
    static constexpr bool HAS_MID = false;
    const float* res; float* dst;
    __device__ __forceinline__ void mid(Acc&, const Unit&, int, int, int, int) const {}
    __device__ __forceinline__ void operator()(const Acc& acc, const Unit& u, int wr, int wc, int fr, int fq) const {
        const int row0 = u.pm * 256 + wr * 64 + fr, c0 = u.pn * 256 + wc * 32 + 8 * fq;
#pragma unroll
        for (int ai = 0; ai < 2; ++ai)
#pragma unroll
            for (int m = 0; m < 4; ++m)
#pragma unroll
                for (int bj = 0; bj < 2; ++bj) {
                    const size_t off = (size_t)(row0 + ai * 128 + m * 16) * 1024 + c0 + bj * 128;
                    const f32x4 r0 = *(const f32x4*)(res + off), r1 = *(const f32x4*)(res + off + 4);
                    *(f32x4*)(dst + off) = r0 * DN_ALPHA + acc[ai][bj][m][0]; *(f32x4*)(dst + off + 4) = r1 * DN_ALPHA + acc[ai][bj][m][1]; __builtin_amdgcn_sched_barrier(0);
                }
    }
};
struct EpiFfnIn {
    static constexpr bool HAS_MID = false;
    bf16_t* ACT;
    __device__ __forceinline__ void mid(Acc&, const Unit&, int, int, int, int) const {}
    __device__ __forceinline__ void operator()(const Acc& acc, const Unit& u, int wr, int wc, int fr, int fq) const {
        const int row0 = u.pm * 256 + wr * 64 + fr, c0 = u.pn * 128 + wc * 32 + 8 * fq;
#pragma unroll
        for (int ai = 0; ai < 2; ++ai)
#pragma unroll
            for (int m = 0; m < 4; ++m) {
                f32x4 a0, a1;
#pragma unroll
                for (int j = 0; j < 4; ++j) { a0[j] = siluf_(acc[ai][0][m][0][j]) * acc[ai][1][m][0][j]; a1[j] = siluf_(acc[ai][0][m][1][j]) * acc[ai][1][m][1][j]; }
                *(u32x4*)(ACT + (size_t)(row0 + ai * 128 + m * 16) * DFF + c0) = pack8(a0, a1);
            }
    }
};

__device__ __forceinline__ int perm_in(int n) {
    if (n < 4096) return n;
    if (n < 6144) { const int q = (n - 4096) >> 8, tc = n & 255; return 7168 + 1024 * (tc >> 7) + 128 * q + (tc & 127); }
    if (n < 8192) { const int u = n - 6144, seg = u >> 10, q = (u & 1023) >> 8, tc = u & 255, bj = tc >> 7, hh = (tc & 127) >> 6, i = tc & 63; return 4096 + 1024 * seg + 128 * (2 * q + hh) + 64 * bj + i; }
    return 6144 + (n - 8192);
}
__device__ __forceinline__ int perm_ffi(int n) { const int pn = n >> 8, tc = n & 255; return DFF * (tc >> 7) + 128 * pn + (tc & 127); }

__device__ __forceinline__ void prep_phase(LAS unsigned char* lds, const Args& a) {
    int tid_ = threadIdx.x; asm volatile("" : "+v"(tid_));
    const int tid = tid_, nb = gridDim.x, bid = blockIdx.x;
    unsigned char* ws = a.ws;
    {   const float4* x4 = (const float4*)a.in[0]; u32x2* xb = (u32x2*)(ws + O_XB); const size_t n4 = (size_t)T_ * D_ / 4;
        for (size_t i = (size_t)bid * 512 + tid; i < n4; i += (size_t)nb * 512) { const float4 v = x4[i]; u32x2 w; w.x = cvt_pk_bf16(v.x, v.y); w.y = cvt_pk_bf16(v.z, v.w); xb[i] = w; } }
    {   float* COS = (float*)(ws + O_COS); float* SIN = (float*)(ws + O_SIN);
        for (int i = bid * 512 + tid; i < S_ * 64; i += nb * 512) {
            const int pos = i >> 6, f = i & 63;
            const float inv = exp2f(-(float)f * (13.287712379549449f / 64.0f));
            const float angf = (float)pos * inv;
            const double ang = (double)angf;
            const double j = rint(ang * 0.6366197723675814); const float r = (float)(ang - j * 1.5707963267948966); const float r2 = r * r;
            const float sn = r * (1.0f + r2 * (-1.6666667e-1f + r2 * (8.3333333e-3f + r2 * (-1.9841270e-4f + r2 * (2.7557319e-6f + r2 * (-2.5052108e-8f))))));
            const float cs = 1.0f + r2 * (-0.5f + r2 * (4.1666667e-2f + r2 * (-1.3888889e-3f + r2 * (2.4801587e-5f + r2 * (-2.7557319e-7f + r2 * 2.0876757e-9f)))));
            const int q = ((int)j) & 3;
            const float s = (q == 0) ? sn : (q == 1) ? cs : (q == 2) ? -sn : -cs;
            const float c = (q == 0) ? cs : (q == 1) ? -sn : (q == 2) ? -cs : sn;
            COS[i] = c; SIN[i] = s;
        }
        float* KM = (float*)(ws + O_KM);
        for (int i = bid * 512 + tid; i < 4 * 8 * 16 * 128; i += nb * 512) KM[i] = 0.f;
        float* LB = (float*)(ws + O_LB); const float* lbl = a.in[2];
        for (int i = bid * 512 + tid; i < 1024; i += nb * 512) LB[i] = 1.0f / (1.0f + expf(lbl[1024 + i] - lbl[i]));
    }
    LAS float* tl = (LAS float*)lds;
    for (int ti = bid; ti < 5184; ti += nb) {
        const float* src; bf16_t* dst; int nsrc, ldd, koff, ntn, mode, loc;
        if (ti < 2304) { src = a.in[1]; dst = (bf16_t*)(ws + O_WIN); nsrc = 9216; ldd = 1024; koff = 0; ntn = 144; mode = 1; loc = ti; }
        else if (ti < 2560) { src = a.in[5]; dst = (bf16_t*)(ws + O_WBR); nsrc = 1024; ldd = 2048; koff = 0; ntn = 16; mode = 0; loc = ti - 2304; }
        else if (ti < 2816) { src = a.in[4]; dst = (bf16_t*)(ws + O_WBR); nsrc = 1024; ldd = 2048; koff = 1024; ntn = 16; mode = 0; loc = ti - 2560; }
        else if (ti < 3072) { src = a.in[7]; dst = (bf16_t*)(ws + O_WOUT); nsrc = 1024; ldd = 1024; koff = 0; ntn = 16; mode = 0; loc = ti - 2816; }
        else if (ti < 4480) { src = a.in[10]; dst = (bf16_t*)(ws + O_WFI); nsrc = 5632; ldd = 1024; koff = 0; ntn = 88; mode = 2; loc = ti - 3072; }
        else { src = a.in[11]; dst = (bf16_t*)(ws + O_WFD); nsrc = 1024; ldd = 2816; koff = 0; ntn = 16; mode = 0; loc = ti - 4480; }
        const int n0 = (loc % ntn) * 64, k0 = (loc / ntn) * 64;
        {   const int nn = tid & 63, kk0 = tid >> 6; const int n = n0 + nn; const int on = mode == 1 ? perm_in(n) : (mode == 2 ? perm_ffi(n) : n);
#pragma unroll
            for (int i = 0; i < 8; ++i) { const int kk = kk0 + 8 * i; tl[kk * 65 + nn] = src[(size_t)(k0 + kk) * nsrc + on]; } }
        __syncthreads();
        {   const int nn = tid >> 3, kc = tid & 7; float v[8];
#pragma unroll
            for (int e = 0; e < 8; ++e) v[e] = tl[(8 * kc + e) * 65 + nn];
            u32x4 w; w.x = cvt_pk_bf16(v[0], v[1]); w.y = cvt_pk_bf16(v[2], v[3]); w.z = cvt_pk_bf16(v[4], v[5]); w.w = cvt_pk_bf16(v[6], v[7]);
            *(u32x4*)(dst + (size_t)(n0 + nn) * ldd + koff + k0 + 8 * kc) = w; }
        __syncthreads();
    }
}

constexpr int HQ = 0, HK = 17408, HKT = 34816, HVT = 53248, HP = 71680, HST = 80896, HEG = 115712, HGS = 116224, HRS = 118272;
__device__ __forceinline__ f32x4 mfma16(bf16x8 a, bf16x8 b, f32x4 c) { return __builtin_amdgcn_mfma_f32_16x16x32_bf16(a, b, c, 0, 0, 0); }
template <bool FULL>
__device__ __forceinline__ void hgrn_item(LAS unsigned char* lds, const Args& a, int item) {
    unsigned char* ws = a.ws;
    int tid_ = threadIdx.x; asm volatile("" : "+v"(tid_));
    const int tid = tid_, wid = tid >> 6, lane = tid & 63, fr = lane & 15, g = lane >> 4;
    const int b = item >> 6, h = (item >> 3) & 7, seg = item & 7;
    const int tok0 = b * S_ + seg * 512, col0 = h * 128;
    const bf16_t* QF = (const bf16_t*)(ws + O_QF); const _Float16* LF = (const _Float16*)(ws + O_LF); const bf16_t* VH = (const bf16_t*)(ws + O_VH); const bf16_t* SG = (const bf16_t*)(ws + O_SG);
    bf16_t* YA = (bf16_t*)(ws + O_YA); float* SEG = (float*)(ws + O_SEG); float* GT = (float*)(ws + O_GT);
    LAS float* EG = (LAS float*)(lds + HEG); LAS float* GS = (LAS float*)(lds + HGS); LAS float* RS = (LAS float*)(lds + HRS);
    f32x4 st[8];
#pragma unroll
    for (int vt = 0; vt < 8; ++vt) st[vt] = (f32x4){0.f, 0.f, 0.f, 0.f};
    if (FULL) {
        for (int i = 0; i < seg; ++i) {
            const int it = item - seg + i;
            const float* sp = SEG + (size_t)it * 16384; const float* gp = GT + it * 128;
            float e[4];
#pragma unroll
            for (int r = 0; r < 4; ++r) e[r] = __expf(gp[16 * wid + 4 * g + r]);
#pragma unroll
            for (int vt = 0; vt < 8; ++vt)
#pragma unroll
                for (int r = 0; r < 4; ++r) st[vt][r] = e[r] * st[vt][r] + sp[(16 * wid + 4 * g + r) * 128 + 16 * vt + fr];
        }
    }
    const int d = tid & 127, tg = tid >> 7;
    float gsum = 0.f;
    for (int c = 0; c < 8; ++c) {
        const int t0 = tok0 + 64 * c;
        const size_t gb = (size_t)(t0 + 16 * tg) * 1024 + col0 + d;
        float lf[16], G[16];
        unsigned short vv[16], qq[16];
#pragma unroll
        for (int j = 0; j < 16; ++j) { lf[j] = (float)LF[gb + (size_t)j * 1024]; vv[j] = VH[gb + (size_t)j * 1024]; if (FULL) qq[j] = QF[gb + (size_t)j * 1024]; }
        float run = 0.f;
#pragma unroll
        for (int j = 0; j < 16; ++j) { run += lf[j]; G[j] = run; }
        GS[tg * 128 + d] = run;
        __syncthreads();
        const float g0 = GS[d], g1 = GS[128 + d], g2 = GS[256 + d], g3 = GS[384 + d];
        const float pre = tg == 0 ? 0.f : (tg == 1 ? g0 : (tg == 2 ? g0 + g1 : g0 + g1 + g2));
        const float glast = g0 + g1 + g2 + g3;
        if (tg == 0) EG[d] = __expf(glast);
        gsum += glast;
        {
            unsigned kp[8], vp[8];
#pragma unroll
            for (int j = 0; j < 16; j += 2) {
                const float G0 = G[j] + pre, G1 = G[j + 1] + pre;
                const float k0 = (1.0f - __expf(lf[j])) * __expf(-G0), k1 = (1.0f - __expf(lf[j + 1])) * __expf(-G1);
                const unsigned kw = cvt_pk_bf16(k0, k1);
                kp[j >> 1] = kw; vp[j >> 1] = (unsigned)vv[j] | ((unsigned)vv[j + 1] << 16);
                if (FULL) {
                    const unsigned qw = cvt_pk_bf16(bf2f(qq[j]) * __expf(G0), bf2f(qq[j + 1]) * __expf(G1));
                    *(LAS unsigned short*)(lds + HK + (16 * tg + j) * 272 + d * 2) = (unsigned short)(kw & 0xffff);
                    *(LAS unsigned short*)(lds + HK + (16 * tg + j + 1) * 272 + d * 2) = (unsigned short)(kw >> 16);
                    *(LAS unsigned short*)(lds + HQ + (16 * tg + j) * 272 + d * 2) = (unsigned short)(qw & 0xffff);
                    *(LAS unsigned short*)(lds + HQ + (16 * tg + j + 1) * 272 + d * 2) = (unsigned short)(qw >> 16);
                }
            }
            *(LAS u32x4*)(lds + HKT + d * 144 + tg * 32) = (u32x4){kp[0], kp[1], kp[2], kp[3]}; *(LAS u32x4*)(lds + HKT + d * 144 + tg * 32 + 16) = (u32x4){kp[4], kp[5], kp[6], kp[7]};
            *(LAS u32x4*)(lds + HVT + d * 144 + tg * 32) = (u32x4){vp[0], vp[1], vp[2], vp[3]}; *(LAS u32x4*)(lds + HVT + d * 144 + tg * 32 + 16) = (u32x4){vp[4], vp[5], vp[6], vp[7]};
        }
        if (FULL) {
#pragma unroll
            for (int vt = 0; vt < 8; ++vt) { u32x2 w; w.x = cvt_pk_bf16(st[vt][0], st[vt][1]); w.y = cvt_pk_bf16(st[vt][2], st[vt][3]);
                *(LAS u32x2*)(lds + HST + (16 * vt + fr) * 272 + (16 * wid + 4 * g) * 2) = w; }
        }
        __syncthreads();
        if (FULL) {
#pragma unroll
            for (int q = 0; q < 2; ++q) {
                const int idx = 2 * wid + q, stl = idx >> 2, ttl = idx & 3;
                f32x4 sc = {0.f, 0.f, 0.f, 0.f};
                if (stl <= ttl) {
#pragma unroll
                    for (int kk = 0; kk < 4; ++kk) {
                        const bf16x8 ka = *(const LAS bf16x8*)(lds + HK + (16 * stl + fr) * 272 + (32 * kk + 8 * g) * 2);
                        const bf16x8 qb = *(const LAS bf16x8*)(lds + HQ + (16 * ttl + fr) * 272 + (32 * kk + 8 * g) * 2);
                        sc = mfma16(ka, qb, sc);
                    }
                }
                const int tq = 16 * ttl + fr, s0 = 16 * stl + 4 * g;
                u32x2 w; w.x = cvt_pk_bf16(s0 <= tq ? sc[0] : 0.f, s0 + 1 <= tq ? sc[1] : 0.f); w.y = cvt_pk_bf16(s0 + 2 <= tq ? sc[2] : 0.f, s0 + 3 <= tq ? sc[3] : 0.f);
                *(LAS u32x2*)(lds + HP + tq * 144 + s0 * 2) = w;
            }
        }
        f32x4 oacc[4];
        if (FULL) {
            const int ttl = wid & 3;
#pragma unroll
            for (int i = 0; i < 4; ++i) {
                const int vt = 4 * (wid >> 2) + i; f32x4 o = {0.f, 0.f, 0.f, 0.f};
#pragma unroll
                for (int kk = 0; kk < 4; ++kk) {
                    const bf16x8 sa = *(const LAS bf16x8*)(lds + HST + (16 * vt + fr) * 272 + (32 * kk + 8 * g) * 2);
                    const bf16x8 qb = *(const LAS bf16x8*)(lds + HQ + (16 * ttl + fr) * 272 + (32 * kk + 8 * g) * 2);
                    o = mfma16(sa, qb, o);
                }
                oacc[i] = o;
            }
        }
        {
            bf16x8 ka[2];
#pragma unroll
            for (int kk = 0; kk < 2; ++kk) ka[kk] = *(const LAS bf16x8*)(lds + HKT + (16 * wid + fr) * 144 + (32 * kk + 8 * g) * 2);
            float eg[4];
#pragma unroll
            for (int r = 0; r < 4; ++r) eg[r] = EG[16 * wid + 4 * g + r];
#pragma unroll
            for (int vt = 0; vt < 8; ++vt) {
                f32x4 L = st[vt];
#pragma unroll
                for (int kk = 0; kk < 2; ++kk) { const bf16x8 vb = *(const LAS bf16x8*)(lds + HVT + (16 * vt + fr) * 144 + (32 * kk + 8 * g) * 2); L = mfma16(ka[kk], vb, L); }
#pragma unroll
                for (int r = 0; r < 4; ++r) st[vt][r] = eg[r] * L[r];
            }
        }
        if (FULL) {
            __syncthreads();
            const int ttl = wid & 3, tq = 16 * ttl + fr;
            float ss = 0.f;
#pragma unroll
            for (int i = 0; i < 4; ++i) {
                const int vt = 4 * (wid >> 2) + i; f32x4 o = oacc[i];
#pragma unroll
                for (int kk = 0; kk < 2; ++kk) {
                    const bf16x8 va = *(const LAS bf16x8*)(lds + HVT + (16 * vt + fr) * 144 + (32 * kk + 8 * g) * 2);
                    const bf16x8 pb = *(const LAS bf16x8*)(lds + HP + tq * 144 + (32 * kk + 8 * g) * 2);
                    o = mfma16(va, pb, o);
                }
                oacc[i] = o; ss += o[0] * o[0] + o[1] * o[1] + o[2] * o[2] + o[3] * o[3];
            }
            ss += __shfl_xor(ss, 16); ss += __shfl_xor(ss, 32);
            if (g == 0) RS[(wid >> 2) * 64 + tq] = ss;
            __syncthreads();
            const float rn = rsqrtf((RS[tq] + RS[64 + tq]) * (1.0f / 128.0f) + 1e-6f);
            const float* nw = a.in[3] + col0;
#pragma unroll
            for (int i = 0; i < 4; ++i) {
                const int v0 = 16 * (4 * (wid >> 2) + i) + 4 * g;
                const size_t off = (size_t)(t0 + tq) * 1024 + col0 + v0;
                const u32x2 sg = *(const u32x2*)(SG + off); const f32x4 w4 = *(const f32x4*)(nw + v0);
                u32x2 w; w.x = cvt_pk_bf16(oacc[i][0] * rn * w4[0] * bflo(sg.x), oacc[i][1] * rn * w4[1] * bfhi(sg.x));
                w.y = cvt_pk_bf16(oacc[i][2] * rn * w4[2] * bflo(sg.y), oacc[i][3] * rn * w4[3] * bfhi(sg.y));
                *(u32x2*)(YA + off) = w;
            }
        }
    }
    if (!FULL) {
        float* sp = SEG + (size_t)item * 16384;
#pragma unroll
        for (int vt = 0; vt < 8; ++vt)
#pragma unroll
            for (int r = 0; r < 4; ++r) sp[(16 * wid + 4 * g + r) * 128 + 16 * vt + fr] = st[vt][r];
        if (tg == 0) GT[item * 128 + d] = gsum;
    }
    __syncthreads();
}

namespace att {
typedef float f32x16 __attribute__((ext_vector_type(16)));
constexpr int SHM_V = 16384, SHM_K = 16384, OFF_K = 2 * SHM_V, OFF_WS = 2 * SHM_V + 2 * SHM_K, OFF_KM = OFF_WS + 2048, OFF_SEL = OFF_KM + 8192;
constexpr float SCALE = 0.088388347648318440f, THR = 8.f;
#define KSWZ(row, colB) ((row) * 256 + ((colB) ^ (((row) & 7) << 4)))
#define SBAR() __builtin_amdgcn_sched_barrier(0)
__device__ __forceinline__ int crow(int r, int hi) { return (r & 3) + 8 * (r >> 2) + 4 * hi; }
__device__ __forceinline__ unsigned cvtpk(float lo, float hi) { unsigned r; asm volatile("v_cvt_pk_bf16_f32 %0, %1, %2" : "=v"(r) : "v"(lo), "v"(hi)); return r; }
__device__ __forceinline__ void partialSM(f32x16& p0, f32x16& p1, float& m_reg, float& mn, float& alpha, int tile, int j, unsigned selm, int wid, int r32, int hi) {
  constexpr float C = SCALE * 1.4426950408889634f;
  const int n = tile >> 2, kt = tile & 3;
  if (n < j) {
    if (!((selm >> n) & 1u)) {
#pragma unroll
      for (int r = 0; r < 16; ++r) { p0[r] = -INFINITY; p1[r] = -INFINITY; } }
  } else if (64 * kt + 63 > 32 * wid) {
    const int qpos = 32 * wid + r32;
#pragma unroll
    for (int r = 0; r < 16; ++r) { const int kp = 64 * kt + crow(r, hi); if (kp > qpos) p0[r] = -INFINITY; if (kp + 32 > qpos) p1[r] = -INFINITY; }
  }
  float pmax = p0[0];
#pragma unroll
  for (int r = 1; r < 16; ++r) pmax = fmaxf(pmax, p0[r]);
#pragma unroll
  for (int r = 0; r < 16; ++r) pmax = fmaxf(pmax, p1[r]);
  { auto rr = __builtin_amdgcn_permlane32_swap(__float_as_uint(pmax), __float_as_uint(pmax), false, false);
    pmax = fmaxf(__uint_as_float(rr[0]), __uint_as_float(rr[1])); }
  if (__builtin_expect(__all(pmax - m_reg <= THR / SCALE), 1)) { mn = m_reg; alpha = 1.f; }
  else { mn = fmaxf(m_reg, pmax); alpha = __builtin_amdgcn_exp2f((m_reg - mn) * C); m_reg = mn; }
  const float mnC = -mn * C;
#pragma unroll
  for (int r = 0; r < 16; ++r) p0[r] = fmaf(p0[r], C, mnC);
#pragma unroll
  for (int r = 0; r < 16; ++r) p1[r] = fmaf(p1[r], C, mnC);
#pragma unroll
  for (int r = 0; r < 16; ++r) p0[r] = __builtin_amdgcn_exp2f(p0[r]);
}
__device__ __forceinline__ void finishSM(f32x16& p0, f32x16& p1, float alpha, float& l_reg, bf16x8& pa0, bf16x8& pa1, bf16x8& pa2, bf16x8& pa3) {
#pragma unroll
  for (int r = 0; r < 16; ++r) p1[r] = __builtin_amdgcn_exp2f(p1[r]);
  float ps = 0;
#pragma unroll
  for (int r = 0; r < 16; ++r) ps += p0[r];
#pragma unroll
  for (int r = 0; r < 16; ++r) ps += p1[r];
  { auto rr = __builtin_amdgcn_permlane32_swap(__float_as_uint(ps), __float_as_uint(ps), false, false);
    ps = __uint_as_float(rr[0]) + __uint_as_float(rr[1]); }
  l_reg = l_reg * alpha + ps;
#define PK4(P, BASE, OUT) do { unsigned a0 = cvtpk(P[BASE + 0], P[BASE + 1]), a1 = cvtpk(P[BASE + 2], P[BASE + 3]);   \
    unsigned b0 = cvtpk(P[BASE + 4], P[BASE + 5]), b1 = cvtpk(P[BASE + 6], P[BASE + 7]);                              \
    auto r0 = __builtin_amdgcn_permlane32_swap(a0, b0, false, false); auto r1 = __builtin_amdgcn_permlane32_swap(a1, b1, false, false); \
    u32x4 w = {r0[0], r1[0], r0[1], r1[1]}; OUT = __builtin_bit_cast(bf16x8, w); } while (0)
  PK4(p0, 0, pa0); PK4(p0, 8, pa1); PK4(p1, 0, pa2); PK4(p1, 8, pa3);
#undef PK4
}
__device__ __forceinline__ void qkt(f32x16& p0, f32x16& p1, LAS const unsigned char* Ks, const bf16x8 (&qr)[8], int r32, int hi) {
  p0 = f32x16{}; p1 = f32x16{};
#pragma unroll
  for (int d0 = 0; d0 < 8; ++d0) { const int cb = (d0 * 16 + hi * 8) * 2;
    const bf16x8 b0 = *(LAS const bf16x8*)(Ks + KSWZ(r32, cb));
    const bf16x8 b1 = *(LAS const bf16x8*)(Ks + KSWZ(32 + r32, cb));
    p0 = __builtin_amdgcn_mfma_f32_32x32x16_bf16(b0, qr[d0], p0, 0, 0, 0);
    p1 = __builtin_amdgcn_mfma_f32_32x32x16_bf16(b1, qr[d0], p1, 0, 0, 0); }
}
__device__ __forceinline__ int v_st(int k, int c) { const int kk = (k & ~0xC) | ((k & 4) << 1) | ((k & 8) >> 1); return ((kk >> 3) * 4 + (c >> 5)) * 512 + ((kk & 7) * 32 + (c & 31)) * 2; }
__device__ __forceinline__ int v_rd_base(int lane) { return ((lane & 3) << 3) | (((lane >> 2) & 3) << 6) | (((lane >> 4) & 1) << 5) | (((lane >> 5) & 1) << 8); }
constexpr int v_rd_off(int d0, int ks, int half) { return d0 * 512 + ks * 4096 + half * 2048; }
template <int OFF> __device__ __forceinline__ s16x4 tr_read(int vb) { s16x4 r; asm volatile("ds_read_b64_tr_b16 %0, %1 offset:%2" : "=&v"(r) : "v"(vb), "i"(OFF) : "memory"); return r; }
template <int D0> __device__ __forceinline__ void pv_one(f32x16& od, int vb, bf16x8 pa0, bf16x8 pa1, bf16x8 pa2, bf16x8 pa3) {
  const s16x4 l0 = tr_read<v_rd_off(D0, 0, 0)>(vb), h0 = tr_read<v_rd_off(D0, 0, 1)>(vb), l1 = tr_read<v_rd_off(D0, 1, 0)>(vb), h1 = tr_read<v_rd_off(D0, 1, 1)>(vb);
  const s16x4 l2 = tr_read<v_rd_off(D0, 2, 0)>(vb), h2 = tr_read<v_rd_off(D0, 2, 1)>(vb), l3 = tr_read<v_rd_off(D0, 3, 0)>(vb), h3 = tr_read<v_rd_off(D0, 3, 1)>(vb);
  asm volatile("s_waitcnt lgkmcnt(0)" ::: "memory"); SBAR();
#define PK(L, H) (bf16x8){L[0], L[1], L[2], L[3], H[0], H[1], H[2], H[3]}
  od = __builtin_amdgcn_mfma_f32_32x32x16_bf16(pa0, PK(l0, h0), od, 0, 0, 0);
  od = __builtin_amdgcn_mfma_f32_32x32x16_bf16(pa1, PK(l1, h1), od, 0, 0, 0);
  od = __builtin_amdgcn_mfma_f32_32x32x16_bf16(pa2, PK(l2, h2), od, 0, 0, 0);
  od = __builtin_amdgcn_mfma_f32_32x32x16_bf16(pa3, PK(l3, h3), od, 0, 0, 0);
#undef PK
}
__device__ __forceinline__ void pv_d0(f32x16 (&o)[4], int vb, bf16x8 pa0, bf16x8 pa1, bf16x8 pa2, bf16x8 pa3) {
  pv_one<0>(o[0], vb, pa0, pa1, pa2, pa3); pv_one<1>(o[1], vb, pa0, pa1, pa2, pa3); pv_one<2>(o[2], vb, pa0, pa1, pa2, pa3); pv_one<3>(o[3], vb, pa0, pa1, pa2, pa3);
}
}

__device__ __forceinline__ void moba_item(LAS unsigned char* lds, const Args& a, int b, int h, int j) {
    using namespace att;
    unsigned char* ws_ = a.ws;
    int tid_ = threadIdx.x; asm volatile("" : "+v"(tid_));
    const int tid = tid_, wid = __builtin_amdgcn_readfirstlane(tid >> 6), lane = tid & 63, r32 = lane & 31, hi = lane >> 5;
    const bf16_t* MQ = (const bf16_t*)(ws_ + O_MQ); const bf16_t* MK = (const bf16_t*)(ws_ + O_MK); const bf16_t* MV = (const bf16_t*)(ws_ + O_MV);
    bf16_t* YB = (bf16_t*)(ws_ + O_YB); const float* KMg = (const float*)(ws_ + O_KM) + (size_t)(b * 8 + h) * 2048;
    const int tokb = b * S_, qrow0 = tokb + 256 * j, col0 = h * 128;
    LAS float* KM = (LAS float*)(lds + OFF_KM); LAS unsigned* SEL = (LAS unsigned*)(lds + OFF_SEL);
    *(LAS f32x4*)(lds + OFF_KM + tid * 16) = *(const f32x4*)(KMg + tid * 4);
    __syncthreads();
    {
        const int q = tid >> 1, half = tid & 1;
        const bf16_t* qp = MQ + (size_t)(qrow0 + q) * 1024 + col0 + 64 * half;
        u32x4 qw[8];
#pragma unroll
        for (int i = 0; i < 8; ++i) qw[i] = *(const u32x4*)(qp + 8 * i);
        float b0 = -INFINITY, b1 = -INFINITY, b2 = -INFINITY; int i0 = -1, i1 = -1, i2 = -1;
        for (int n = 0; n < j; ++n) {
            const LAS float* kp = KM + n * 128 + 64 * half; float s = 0.f;
#pragma unroll
            for (int i = 0; i < 8; ++i) { const f32x4 ka = *(const LAS f32x4*)(kp + 8 * i), kb = *(const LAS f32x4*)(kp + 8 * i + 4);
                s += bflo(qw[i].x) * ka[0] + bfhi(qw[i].x) * ka[1] + bflo(qw[i].y) * ka[2] + bfhi(qw[i].y) * ka[3] + bflo(qw[i].z) * kb[0] + bfhi(qw[i].z) * kb[1] + bflo(qw[i].w) * kb[2] + bfhi(qw[i].w) * kb[3]; }
            s += __shfl_xor(s, 1);
            if (s > b0) { b2 = b1; i2 = i1; b1 = b0; i1 = i0; b0 = s; i0 = n; }
            else if (s > b1) { b2 = b1; i2 = i1; b1 = s; i1 = n; }
            else if (s > b2) { b2 = s; i2 = n; }
        }
        unsigned m = 0; if (i0 >= 0) m |= 1u << i0; if (i1 >= 0) m |= 1u << i1; if (i2 >= 0) m |= 1u << i2;
        if (half == 0) SEL[q] = m;
    }
    __syncthreads();
    const unsigned selm = SEL[32 * wid + r32];
    LAS unsigned char* V_lds = lds; LAS unsigned char* K_lds = lds + OFF_K;
    LAS float* wsl = (LAS float*)(lds + OFF_WS) + wid * 64; LAS float* li_l = wsl; LAS float* al_l = wsl + 32;
    float m_reg = -1e30f, l_reg = 0; f32x16 o[4] = {}; bf16x8 qr[8];
    const bf16_t* Qw = MQ + (size_t)(qrow0 + wid * 32 + r32) * 1024 + col0 + hi * 8;
#pragma unroll
    for (int d0 = 0; d0 < 8; ++d0) qr[d0] = *(const bf16x8*)(Qw + d0 * 16);
    const int sr = tid >> 4, sc = (tid & 15) * 8, vst0 = v_st(sr, sc), vst1 = v_st(32 + sr, sc);
    const int vb0 = (int)(unsigned)(uintptr_t)V_lds + v_rd_base(lane);
    const bf16_t* Kh = MK + (size_t)tokb * 1024 + col0; const bf16_t* Vh = MV + (size_t)tokb * 1024 + col0;
    bf16x8 vsA0, vsA1, ksA0, ksA1, vsB0, vsB1, ksB0, ksB1;
#define SLOADA(k0) do { vsA0 = *(const bf16x8*)(Vh + (size_t)((k0) + sr) * 1024 + sc); vsA1 = *(const bf16x8*)(Vh + (size_t)((k0) + 32 + sr) * 1024 + sc); \
    ksA0 = *(const bf16x8*)(Kh + (size_t)((k0) + sr) * 1024 + sc); ksA1 = *(const bf16x8*)(Kh + (size_t)((k0) + 32 + sr) * 1024 + sc); } while (0)
#define SLOADB(k0) do { vsB0 = *(const bf16x8*)(Vh + (size_t)((k0) + sr) * 1024 + sc); vsB1 = *(const bf16x8*)(Vh + (size_t)((k0) + 32 + sr) * 1024 + sc); \
    ksB0 = *(const bf16x8*)(Kh + (size_t)((k0) + sr) * 1024 + sc); ksB1 = *(const bf16x8*)(Kh + (size_t)((k0) + 32 + sr) * 1024 + sc); } while (0)
#define SWRITEA(bb) do { *(LAS bf16x8*)(V_lds + (bb) * SHM_V + vst0) = vsA0; *(LAS bf16x8*)(V_lds + (bb) * SHM_V + vst1) = vsA1; const int kc = sc * 2; \
    *(LAS bf16x8*)(K_lds + (bb) * SHM_K + KSWZ(sr, kc)) = ksA0; *(LAS bf16x8*)(K_lds + (bb) * SHM_K + KSWZ(32 + sr, kc)) = ksA1; } while (0)
#define SWRITEB(bb) do { *(LAS bf16x8*)(V_lds + (bb) * SHM_V + vst0) = vsB0; *(LAS bf16x8*)(V_lds + (bb) * SHM_V + vst1) = vsB1; const int kc = sc * 2; \
    *(LAS bf16x8*)(K_lds + (bb) * SHM_K + KSWZ(sr, kc)) = ksB0; *(LAS bf16x8*)(K_lds + (bb) * SHM_K + KSWZ(32 + sr, kc)) = ksB1; } while (0)
#define SWAIT() asm volatile("s_waitcnt vmcnt(4)" ::: "memory")
#define RESC(a_) do { if (__any((a_) < 1.f)) { if (hi == 0) al_l[r32] = (a_); asm volatile("s_waitcnt lgkmcnt(0)" ::: "memory"); \
    _Pragma("unroll") for (int d = 0; d < 4; ++d) _Pragma("unroll") for (int r = 0; r < 16; ++r) o[d][r] *= al_l[crow(r, hi)]; } } while (0)
    f32x16 pA0, pA1, pB0, pB1; float mnA, mnB, alA, alB; bf16x8 pa0, pa1, pa2, pa3; const int NT = 4 * (j + 1);
    SLOADA(0); asm volatile("s_waitcnt vmcnt(0)" ::: "memory"); SWRITEA(0); __syncthreads();
    qkt(pA0, pA1, K_lds, qr, r32, hi); partialSM(pA0, pA1, m_reg, mnA, alA, 0, j, selm, wid, r32, hi);
    SLOADB(64); if (2 < NT) SLOADA(128);
    SWAIT(); SWRITEB(1); __syncthreads();
    for (int t = 1; t + 1 < NT; t += 2) {
        SBAR(); qkt(pB0, pB1, K_lds + SHM_K, qr, r32, hi);
        finishSM(pA0, pA1, alA, l_reg, pa0, pa1, pa2, pa3); SBAR();
        SLOADB((t + 2) * 64); SBAR();
        pv_d0(o, vb0, pa0, pa1, pa2, pa3); partialSM(pB0, pB1, m_reg, mnB, alB, t, j, selm, wid, r32, hi);
        __syncthreads(); SWAIT(); SWRITEA(0);
        RESC(alB); __syncthreads();
        SBAR(); qkt(pA0, pA1, K_lds, qr, r32, hi);
        finishSM(pB0, pB1, alB, l_reg, pa0, pa1, pa2, pa3); SBAR();
        if (t + 3 < NT) SLOADA((t + 3) * 64); SBAR();
        pv_d0(o, vb0 + SHM_V, pa0, pa1, pa2, pa3); partialSM(pA0, pA1, m_reg, mnA, alA, t + 1, j, selm, wid, r32, hi);
        __syncthreads(); SWAIT(); SWRITEB(1);
        RESC(alA); __syncthreads();
    }
    SBAR(); qkt(pB0, pB1, K_lds + SHM_K, qr, r32, hi);
    finishSM(pA0, pA1, alA, l_reg, pa0, pa1, pa2, pa3); SBAR();
    pv_d0(o, vb0, pa0, pa1, pa2, pa3); partialSM(pB0, pB1, m_reg, mnB, alB, NT - 1, j, selm, wid, r32, hi);
    __syncthreads(); RESC(alB);
    finishSM(pB0, pB1, alB, l_reg, pa0, pa1, pa2, pa3); SBAR();
    pv_d0(o, vb0 + SHM_V, pa0, pa1, pa2, pa3);
    if (hi == 0) li_l[r32] = l_reg; asm volatile("s_waitcnt lgkmcnt(0)" ::: "memory");
    float rli[16];
#pragma unroll
    for (int r = 0; r < 16; ++r) rli[r] = __builtin_amdgcn_rcpf(li_l[crow(r, hi)]);
    bf16_t* Ow = YB + (size_t)(qrow0 + wid * 32) * 1024 + col0;
#pragma unroll
    for (int r = 0; r < 16; ++r) { const int orow = crow(r, hi);
#pragma unroll
        for (int d0 = 0; d0 < 4; ++d0) Ow[(size_t)orow * 1024 + d0 * 32 + r32] = (bf16_t)(cvt_pk_bf16(o[d0][r] * rli[r], 0.f) & 0xffffu); }
    asm volatile("s_waitcnt vmcnt(0)" ::: "memory");
    __syncthreads();
#undef SLOADA
#undef SLOADB
#undef SWRITEA
#undef SWRITEB
#undef SWAIT
#undef RESC
}

__device__ __forceinline__ void ln_phase(const float* src, const float* w, const float* bsh, float* dstf, bf16_t* dstb) {
    int tid_ = threadIdx.x; asm volatile("" : "+v"(tid_));
    const int tid = tid_, wid = tid >> 6, lane = tid & 63;
    for (int row = blockIdx.x * 8 + wid; row < T_; row += gridDim.x * 8) {
        const float* p = src + (size_t)row * 1024;
        f32x4 v[4]; float s = 0.f;
#pragma unroll
        for (int i = 0; i < 4; ++i) { v[i] = *(const f32x4*)(p + 256 * i + 4 * lane); s += v[i][0] + v[i][1] + v[i][2] + v[i][3]; }
#pragma unroll
        for (int sh = 1; sh < 64; sh <<= 1) s += __shfl_xor(s, sh);
        const float mu = s * (1.0f / 1024.0f); float q = 0.f;
#pragma unroll
        for (int i = 0; i < 4; ++i) { v[i] -= mu; q += v[i][0] * v[i][0] + v[i][1] * v[i][1] + v[i][2] * v[i][2] + v[i][3] * v[i][3]; }
#pragma unroll
        for (int sh = 1; sh < 64; sh <<= 1) q += __shfl_xor(q, sh);
        const float rs = rsqrtf(q * (1.0f / 1024.0f) + 1e-5f);
#pragma unroll
        for (int i = 0; i < 4; ++i) {
            const int c = 256 * i + 4 * lane;
            const f32x4 y = v[i] * rs * *(const f32x4*)(w + c) + *(const f32x4*)(bsh + c);
            *(f32x4*)(dstf + (size_t)row * 1024 + c) = y;
            if (dstb) { u32x2 o; o.x = cvt_pk_bf16(y[0], y[1]); o.y = cvt_pk_bf16(y[2], y[3]); *(u32x2*)(dstb + (size_t)row * 1024 + c) = o; }
        }
    }
}


#define XB_TMO      128
#define XB_XCNT(j)  (256  + 64 * (j))
#define XB_XSUB(j)  (1280 + 64 * (j))
#define XB_XGEN(j)  (2304 + 64 * (j))
#define XB_TOP      3328
#define XB_TOPGEN   3392
#define XCD_BAR_WORDS 3456
#define XB_SPIN_CAP (1u << 18)
__device__ __forceinline__ unsigned xb_ld(unsigned* p)              { return __hip_atomic_load(p, __ATOMIC_RELAXED, __HIP_MEMORY_SCOPE_AGENT); }
__device__ __forceinline__ unsigned xb_add(unsigned* p, unsigned v) { return __hip_atomic_fetch_add(p, v, __ATOMIC_RELAXED, __HIP_MEMORY_SCOPE_AGENT); }
__device__ __forceinline__ unsigned xb_xcc_id() { return (unsigned)__builtin_amdgcn_s_getreg((3 << 11) | 20) & 0xFu; }
#define XB_SPIN(cond, bar) do { unsigned _sp = 0; while (cond) { __builtin_amdgcn_s_sleep(1); \
    if ((++_sp & 255u) == 0u) { if (xb_ld(&(bar)[XB_TMO])) break; if (_sp > XB_SPIN_CAP) { atomicAdd(&(bar)[XB_TMO], 1u); break; } } } } while (0)
struct XcdBarrier { unsigned* bar; unsigned x; volatile LAS unsigned* st; };
__device__ __forceinline__ XcdBarrier xcd_barrier_post(unsigned* bar, volatile LAS unsigned* st) {
    XcdBarrier b; b.bar = bar; b.x = xb_xcc_id(); b.st = st;
    if (threadIdx.x == 0) (void)xb_add(&bar[XB_XCNT(b.x)], 1u);
    return b;
}
__device__ __forceinline__ void xcd_barrier_complete(unsigned* bar, unsigned x, unsigned& nloc, unsigned& nx) {
    const unsigned G = gridDim.x * gridDim.y * gridDim.z;
    unsigned sum, cnt, mine, sp = 0u;
    for (;;) {
        sum = 0u; cnt = 0u; mine = 0u;
#pragma unroll
        for (unsigned j = 0; j < 16; ++j) { const unsigned c = xb_ld(&bar[XB_XCNT(j)]); sum += c; cnt += (c > 0u) ? 1u : 0u; mine = (j == x) ? c : mine; }
        if (sum == G) break;
        __builtin_amdgcn_s_sleep(1);
        if ((++sp & 255u) == 0u) { if (xb_ld(&bar[XB_TMO])) break; if (sp > XB_SPIN_CAP) { atomicAdd(&bar[XB_TMO], 1u); break; } }
    }
    nloc = mine > 0u ? mine : 1u; nx = cnt > 0u ? cnt : 1u;
}
__device__ __forceinline__ void xcd_barrier(const XcdBarrier& b) {
    asm volatile("s_waitcnt vmcnt(0)" ::: "memory");
    __syncthreads();
    if (threadIdx.x == 0) {
        unsigned* bar = b.bar;
        __builtin_amdgcn_s_waitcnt(0);
        unsigned nloc = b.st[0], nx = b.st[1];
        if (nloc == 0u) { xcd_barrier_complete(bar, b.x, nloc, nx); b.st[0] = nloc; b.st[1] = nx; }
        const unsigned old = xb_add(&bar[XB_XSUB(b.x)], 1u);
        const unsigned gen = old / nloc;
        if (old + 1u == (gen + 1u) * nloc) {
            __builtin_amdgcn_fence(__ATOMIC_RELEASE, "agent");
            asm volatile("s_waitcnt vmcnt(0)" ::: "memory");
            const unsigned og = xb_add(&bar[XB_TOP], 1u);
            const unsigned tg = og / nx;
            if (og + 1u == (tg + 1u) * nx) xb_add(&bar[XB_TOPGEN], 1u);
            else XB_SPIN(xb_ld(&bar[XB_TOPGEN]) == tg, bar);
            __builtin_amdgcn_fence(__ATOMIC_ACQUIRE, "agent");
            xb_add(&bar[XB_XGEN(b.x)], 1u);
            asm volatile("s_waitcnt vmcnt(0)" ::: "memory");
        } else {
            XB_SPIN(xb_ld(&bar[XB_XGEN(b.x)]) == gen, bar);
            __builtin_amdgcn_fence(__ATOMIC_ACQUIRE, "agent");
            asm volatile("s_waitcnt vmcnt(0)" ::: "memory");
        }
    }
    __syncthreads();
}

__global__ void __launch_bounds__(512, 2) hybrid_fwd(Args a) {
    extern __shared__ __attribute__((aligned(16))) unsigned char lds_raw[];
    LAS unsigned char* lds = (LAS unsigned char*)lds_raw;
    unsigned char* ws = a.ws;
    pg8::StaticOrder S;
    if (threadIdx.x == 0) { *(LAS unsigned*)(lds + 131072) = 0u; *(LAS unsigned*)(lds + 131076) = 0u; }
    __syncthreads();
    const XcdBarrier xbar = xcd_barrier_post((unsigned*)(ws + O_BAR), (volatile LAS unsigned*)(lds + 131072));
    for (int ph = a.ph_lo; ph < a.ph_hi; ++ph) {
      for (int rep = 0; rep < (((REPEAT_MASK >> ph) & 1) ? 2 : 1); ++rep) {
        switch (ph) {
        case 0: prep_phase(lds, a); break;
        case 1: { pg8::Gemm g{(const bf16_t*)(ws + O_XB), (const bf16_t*)(ws + O_XB), (const bf16_t*)(ws + O_WIN), T_, 6144, 1024, 1024, 1 << 20};
            EpiProjA E{(bf16_t*)(ws + O_QF), (_Float16*)(ws + O_LF), (bf16_t*)(ws + O_VH), (bf16_t*)(ws + O_SG), (bf16_t*)a.out, (bf16_t*)a.out + (size_t)T_ * 1024, (const float*)(ws + O_LB), a.in[6]};
            S.init(T_, 6144, gridDim.x, blockIdx.x); pg8::gemm_phase(lds, g, S, E); } break;
        case 2: for (int it = blockIdx.x; it < 256; it += gridDim.x) if ((it & 7) != 7) hgrn_item<false>(lds, a, it); break;
        case 3: for (int it = blockIdx.x; it < 256; it += gridDim.x) hgrn_item<true>(lds, a, it); break;
        case 4: { pg8::Gemm g{(const bf16_t*)(ws + O_XB), (const bf16_t*)(ws + O_XB), (const bf16_t*)(ws + O_WIN) + (size_t)6144 * 1024, T_, 3072, 1024, 1024, 1 << 20};
            EpiProjB E{(bf16_t*)(ws + O_MQ), (bf16_t*)(ws + O_MK), (bf16_t*)(ws + O_MV), (float*)(ws + O_KM), (const float*)(ws + O_COS), (const float*)(ws + O_SIN)};
            S.init(T_, 3072, gridDim.x, blockIdx.x); pg8::gemm_phase(lds, g, S, E); } break;
        case 5: for (int pr = blockIdx.x; pr < 256; pr += gridDim.x) { const int bh = pr >> 3, jj = pr & 7; for (int k2 = 0; k2 < 2; ++k2) moba_item(lds, a, bh >> 3, bh & 7, k2 ? jj : 15 - jj); } break;
        case 6: { pg8::Gemm g{(const bf16_t*)(ws + O_YB), (const bf16_t*)(ws + O_YA), (const bf16_t*)(ws + O_WBR), T_, 1024, 2048, 1024, 16};
            EpiBranch E{(const bf16_t*)a.out, (const bf16_t*)a.out + (size_t)T_ * 1024, (bf16_t*)(ws + O_MM)};
            S.init(T_, 1024, gridDim.x, blockIdx.x); pg8::gemm_phase(lds, g, S, E); } break;
        case 7: { pg8::Gemm g{(const bf16_t*)(ws + O_MM), (const bf16_t*)(ws + O_MM), (const bf16_t*)(ws + O_WOUT), T_, 1024, 1024, 1024, 1 << 20};
            EpiRes E{a.in[0], (float*)(ws + O_R1)};
            S.init(T_, 1024, gridDim.x, blockIdx.x); pg8::gemm_phase(lds, g, S, E); } break;
        case 8: ln_phase((const float*)(ws + O_R1), a.in[8], a.in[9], a.out, (bf16_t*)(ws + O_X1B)); break;
        case 9: { pg8::Gemm g{(const bf16_t*)(ws + O_X1B), (const bf16_t*)(ws + O_X1B), (const bf16_t*)(ws + O_WFI), T_, 2 * DFF, 1024, 1024, 1 << 20};
            EpiFfnIn E{(bf16_t*)(ws + O_ACT)};
            S.init(T_, 2 * DFF, gridDim.x, blockIdx.x); pg8::gemm_phase(lds, g, S, E); } break;
        case 10: { pg8::Gemm g{(const bf16_t*)(ws + O_ACT), (const bf16_t*)(ws + O_ACT), (const bf16_t*)(ws + O_WFD), T_, 1024, DFF, DFF, 1 << 20};
            EpiRes E{a.out, (float*)(ws + O_R2)};
            S.init(T_, 1024, gridDim.x, blockIdx.x); pg8::gemm_phase(lds, g, S, E); } break;
        case 11: ln_phase((const float*)(ws + O_R2), a.in[12], a.in[13], a.out, nullptr); break;
        }
      }
        if (ph + 1 < a.ph_hi) { if (ph == 0) cg::this_grid().sync(); else xcd_barrier(xbar); }
    }
}

extern "C" void kernel_launch(void* const* d_in, const int* in_sizes, int n_in, void* d_out, int out_size, void* d_ws, size_t ws_size, hipStream_t stream) {
    static int grid = 0;
    if (grid == 0) {
        int dev = 0, cus = 0, per_cu = 0;
        hipGetDevice(&dev); hipDeviceGetAttribute(&cus, hipDeviceAttributeMultiprocessorCount, dev);
        hipFuncSetAttribute((const void*)hybrid_fwd, hipFuncAttributeMaxDynamicSharedMemorySize, LDS_BYTES);
        hipOccupancyMaxActiveBlocksPerMultiprocessor(&per_cu, (const void*)hybrid_fwd, 512, LDS_BYTES);
        if (per_cu < 1) { fprintf(stderr, "kernel_launch: occupancy query reports %d blocks per CU\n", per_cu); per_cu = 1; }
        if (per_cu > 1) per_cu = 1;
        grid = cus * per_cu;
        if (ws_size < 252 * MB) fprintf(stderr, "kernel_launch: workspace too small: %zu\n", ws_size);
    }
    (void)hipMemsetAsync((unsigned char*)d_ws + O_BAR, 0, XCD_BAR_WORDS * 4, stream);
    Args a{};
    for (int i = 0; i < 14; ++i) a.in[i] = (const float*)d_in[i];
    a.out = (float*)d_out; a.ws = (unsigned char*)d_ws;
#if N_LAUNCH_MODE == 1
    a.ph_lo = 0; a.ph_hi = NPHASE;
    void* args[] = {&a};
    hipError_t e = hipLaunchCooperativeKernel((const void*)hybrid_fwd, dim3(grid), dim3(512), args, LDS_BYTES, stream);
    if (e != hipSuccess) fprintf(stderr, "cooperative launch failed: %s (grid %d)\n", hipGetErrorString(e), grid);
#else
    for (int ph = 0; ph < NPHASE; ++ph) { a.ph_lo = ph; a.ph_hi = ph + 1; hipLaunchKernelGGL(hybrid_fwd, dim3(grid), dim3(512), LDS_BYTES, stream, a); }
#endif
}
```
